# Optimizing an MI355X kernel written in HIP

```python
import math
import jax, jax.numpy as jnp
from jax import lax
import numpy as np

D_MODEL = 1024
BATCH = 4
SEQ = 4096
DEPTH = 2

RET_HEADS = 4
RET_HEAD_DIM = 128
RET_CHUNK = 128
DSA_HEADS = 8
DSA_HEAD_DIM = 64
DSA_PATTERNS = ((128, 1), (512, 4), (2048, 16))
DSA_BLOCK = 128
T5_BUCKETS = 32
T5_MAX_DIST = 2048
MLSTM_HEADS = 4
MLSTM_HEAD_DIM = 256
MLSTM_CHUNK = 128
MLSTM_CONV = 4
D_FF = 2816
FFN_CONV = 3
LN_EPS = 1e-5
DEEPNORM_ALPHA = (2.0 * DEPTH) ** 0.25
DEEPNORM_BETA = (8.0 * DEPTH) ** -0.25

N_EVEN = (DEPTH + 1) // 2
N_ODD = DEPTH // 2
RET_W = RET_HEADS * RET_HEAD_DIM
DSA_W = DSA_HEADS * DSA_HEAD_DIM
MIX_W_EVEN = RET_W + DSA_W
EVEN_IN = 4 * RET_W + 3 * DSA_W
EVEN_SPLITS = (RET_W, 2 * RET_W, 3 * RET_W, 4 * RET_W, 4 * RET_W + DSA_W, 4 * RET_W + 2 * DSA_W)
MLSTM_W = MLSTM_HEADS * MLSTM_HEAD_DIM
ODD_IN = 4 * MLSTM_W + 2 * MLSTM_HEADS
ODD_SPLITS = (2 * MLSTM_W, 3 * MLSTM_W, 4 * MLSTM_W)

kernel_name = "hybrid_retention_dilated_mlstm_deepnorm"


def layer_norm(x, g, b):
    xf = x.astype(jnp.float32)
    mu = jnp.mean(xf, -1, keepdims=True)
    var = jnp.mean(jnp.square(xf - mu), -1, keepdims=True)
    return ((xf - mu) * lax.rsqrt(var + LN_EPS) * g + b).astype(x.dtype)


def head_norm(y):
    mu = jnp.mean(y, -1, keepdims=True)
    var = jnp.mean(jnp.square(y - mu), -1, keepdims=True)
    return (y - mu) * lax.rsqrt(var + LN_EPS)


def split_heads(t, n_heads):
    B, S, W = t.shape
    return t.reshape(B, S, n_heads, W // n_heads).transpose(0, 2, 1, 3)


def merge_heads(t):
    B, H, S, d = t.shape
    return t.transpose(0, 2, 1, 3).reshape(B, S, H * d)


def causal_dwconv(x, w):
    K, C = w.shape
    return lax.conv_general_dilated(x, w[:, None, :].astype(x.dtype), window_strides=(1,), padding=[(K - 1, 0)], dimension_numbers=("NWC", "WIO", "NWC"), feature_group_count=C)


def rotary(x):
    S, d = x.shape[-2], x.shape[-1]
    inv = 1.0 / (10000.0 ** (jnp.arange(0, d, 2, dtype=jnp.float32) / d))
    ang = jnp.arange(S, dtype=jnp.float32)[:, None] * inv[None, :]
    cos, sin = jnp.cos(ang), jnp.sin(ang)
    x1, x2 = x[..., : d // 2], x[..., d // 2:]
    return jnp.concatenate([x1 * cos - x2 * sin, x1 * sin + x2 * cos], -1)


def retention(q, k, v):
    B, H, S, d = q.shape
    C = RET_CHUNK
    N = S // C
    log_gamma = jnp.log1p(-jnp.exp2(-5.0 - jnp.arange(H, dtype=jnp.float32)))
    qf = rotary(q.astype(jnp.float32))
    kf = rotary(k.astype(jnp.float32)) * (d ** -0.5)
    qc = qf.reshape(B, H, N, C, d)
    kc = kf.reshape(B, H, N, C, d)
    vc = v.astype(jnp.float32).reshape(B, H, N, C, d)
    idx = jnp.arange(C, dtype=jnp.float32)
    rel = idx[:, None] - idx[None, :]
    decay = jnp.where(rel >= 0, jnp.exp(log_gamma[:, None, None] * jnp.maximum(rel, 0.0)), 0.0)
    scores = jnp.einsum('bhncd,bhnsd->bhncs', qc, kc) * decay[None, :, None]
    y_intra = jnp.einsum('bhncs,bhnse->bhnce', scores, vc)
    k_w = jnp.exp(log_gamma[:, None] * (C - 1 - idx)[None, :])
    kv = jnp.einsum('bhnsd,bhnse->bhnde', kc * k_w[None, :, None, :, None], vc)
    chunk_decay = jnp.exp(log_gamma * C)[None, :, None, None]

    def step(R, kv_n):
        return chunk_decay * R + kv_n, R

    _, R_prev = lax.scan(step, jnp.zeros((B, H, d, d), jnp.float32), jnp.moveaxis(kv, 2, 0))
    R_prev = jnp.moveaxis(R_prev, 0, 2)
    q_w = jnp.exp(log_gamma[:, None] * (idx + 1.0)[None, :])
    y_inter = jnp.einsum('bhncd,bhnde->bhnce', qc * q_w[None, :, None, :, None], R_prev)
    return (y_intra + y_inter).reshape(B, H, S, d)


def t5_bucket(dist):
    exact = T5_BUCKETS // 2
    n = jnp.maximum(dist, 0)
    large = exact + (jnp.log(jnp.maximum(n, 1).astype(jnp.float32) / exact) / math.log(T5_MAX_DIST / exact) * (T5_BUCKETS - exact)).astype(jnp.int32)
    large = jnp.minimum(large, T5_BUCKETS - 1)
    return jnp.where(n < exact, n, large)


def dilated_branch(q, k, v, rel_bias, window, dilation):
    B, H, S, d = q.shape
    L = S // dilation
    W = window // dilation
    blk = DSA_BLOCK
    nb = -(-L // blk)
    Lp = nb * blk

    def to_blocks(t):
        t = t.astype(jnp.float32).reshape(B, H, L, dilation, d).swapaxes(2, 3)
        t = jnp.pad(t, ((0, 0), (0, 0), (0, 0), (0, Lp - L), (0, 0)))
        return t.reshape(B, H, dilation, nb, blk, d)

    def with_prev(t):
        prev = jnp.pad(t[:, :, :, :-1], ((0, 0), (0, 0), (0, 0), (1, 0), (0, 0), (0, 0)))
        return jnp.concatenate([prev, t], axis=4)

    qb = to_blocks(q)
    kw = with_prev(to_blocks(k))
    vw = with_prev(to_blocks(v))
    qi = jnp.arange(blk)[:, None] + blk
    kj = jnp.arange(2 * blk)[None, :]
    dist = qi - kj
    bias = rel_bias[t5_bucket(dist * dilation)].astype(jnp.float32).transpose(2, 0, 1)
    blk_start = jnp.arange(nb)[:, None, None] * blk
    valid = (dist >= 0) & (dist <= W) & (blk_start + kj - blk >= 0)
    logits = jnp.einsum('bhrnqd,bhrnkd->bhrnqk', qb, kw) * (d ** -0.5) + bias[None, :, None, None]
    logits = jnp.where(valid, logits, -jnp.inf)
    m = jnp.max(logits, -1)
    p = jnp.exp(logits - m[..., None])
    s = jnp.sum(p, -1)
    o = jnp.einsum('bhrnqk,bhrnkd->bhrnqd', p, vw)

    def from_blocks(t):
        tail = t.shape[5:]
        t = t.reshape((B, H, dilation, Lp) + tail)[:, :, :, :L]
        return jnp.swapaxes(t, 2, 3).reshape((B, H, S) + tail)

    return from_blocks(m), from_blocks(s), from_blocks(o)


def dilated_attention(q, k, v, rel_bias):
    outs = [dilated_branch(q, k, v, rel_bias, w, r) for (w, r) in DSA_PATTERNS]
    M = jnp.max(jnp.stack([m for (m, _, _) in outs]), axis=0)
    num = sum(jnp.exp(m - M)[..., None] * o for (m, _, o) in outs)
    den = sum(jnp.exp(m - M) * s for (m, s, _) in outs)
    return num / den[..., None]


def mlstm(q, k, v, log_i, log_f):
    B, H, S, d = q.shape
    C = MLSTM_CHUNK
    N = S // C
    qc = q.astype(jnp.float32).reshape(B, H, N, C, d)
    kc = (k.astype(jnp.float32) * (d ** -0.5)).reshape(B, H, N, C, d)
    vc = v.astype(jnp.float32).reshape(B, H, N, C, d)
    li = log_i.reshape(B, H, N, C)
    a = jnp.cumsum(log_f.reshape(B, H, N, C), axis=-1)
    g = a[..., -1]
    w_state = g[..., None] - a + li
    m_loc = jnp.max(w_state, -1)
    ew = jnp.exp(w_state - m_loc[..., None])[..., None]
    kv = jnp.einsum('bhncd,bhnce->bhnde', kc * ew, vc)
    ksum = jnp.sum(kc * ew, axis=3)

    def step(carry, inp):
        C_s, n_s, m_s = carry
        kv_n, ks_n, g_n, m_n = inp
        m_new = jnp.maximum(g_n + m_s, m_n)
        a_old = jnp.exp(g_n + m_s - m_new)
        a_loc = jnp.exp(m_n - m_new)
        C_new = a_old[..., None, None] * C_s + a_loc[..., None, None] * kv_n
        n_new = a_old[..., None] * n_s + a_loc[..., None] * ks_n
        return (C_new, n_new, m_new), (C_s, n_s, m_s)

    init = (jnp.zeros((B, H, d, d), jnp.float32), jnp.zeros((B, H, d), jnp.float32), jnp.zeros((B, H), jnp.float32))
    xs = (jnp.moveaxis(kv, 2, 0), jnp.moveaxis(ksum, 2, 0), jnp.moveaxis(g, 2, 0), jnp.moveaxis(m_loc, 2, 0))
    _, (C_prev, n_prev, m_prev) = lax.scan(step, init, xs)
    C_prev = jnp.moveaxis(C_prev, 0, 2)
    n_prev = jnp.moveaxis(n_prev, 0, 2)
    m_prev = jnp.moveaxis(m_prev, 0, 2)
    D = a[..., :, None] - a[..., None, :] + li[..., None, :]
    causal = jnp.tril(jnp.ones((C, C), dtype=bool))
    D = jnp.where(causal, D, -jnp.inf)
    inter_log = a + m_prev[..., None]
    m = jnp.maximum(inter_log, jnp.max(D, -1))
    P = jnp.exp(D - m[..., None]) * jnp.einsum('bhncd,bhnsd->bhncs', qc, kc)
    w_inter = jnp.exp(inter_log - m)
    num = jnp.einsum('bhncs,bhnse->bhnce', P, vc) + w_inter[..., None] * jnp.einsum('bhncd,bhnde->bhnce', qc, C_prev)
    den = jnp.sum(P, -1) + w_inter * jnp.einsum('bhncd,bhnd->bhnc', qc, n_prev)
    h = num / jnp.maximum(jnp.abs(den), jnp.exp(-m))[..., None]
    return h.reshape(B, H, S, d)


def even_mixer(x, w_in, w_out, rel_bias):
    h = x @ w_in
    q_r, k_r, v_r, g_r, q_d, k_d, v_d = jnp.split(h, list(EVEN_SPLITS), axis=-1)
    y_r = retention(split_heads(q_r, RET_HEADS), split_heads(k_r, RET_HEADS), split_heads(v_r, RET_HEADS))
    y_r = merge_heads(head_norm(y_r)) * jax.nn.silu(g_r.astype(jnp.float32))
    y_d = merge_heads(dilated_attention(split_heads(q_d, DSA_HEADS), split_heads(k_d, DSA_HEADS), split_heads(v_d, DSA_HEADS), rel_bias))
    y = jnp.concatenate([y_r, y_d], axis=-1).astype(x.dtype)
    return y @ w_out


def odd_mixer(x, w_in, gate_b, conv_w, w_out):
    h = x @ w_in
    qk, v, o, gates = jnp.split(h, list(ODD_SPLITS), axis=-1)
    qk = jax.nn.silu(causal_dwconv(qk, conv_w))
    q, k = jnp.split(qk, 2, axis=-1)
    gates = gates.astype(jnp.float32) + gate_b
    log_i = gates[..., :MLSTM_HEADS].transpose(0, 2, 1)
    log_f = jax.nn.log_sigmoid(gates[..., MLSTM_HEADS:]).transpose(0, 2, 1)
    y = mlstm(split_heads(q, MLSTM_HEADS), split_heads(k, MLSTM_HEADS), split_heads(v, MLSTM_HEADS), log_i, log_f)
    y = merge_heads(y) * jax.nn.sigmoid(o.astype(jnp.float32))
    return y.astype(x.dtype) @ w_out


def conv_ffn(x, w_up, conv_w, conv_b, w_down):
    gate, up = jnp.split(x @ w_up, 2, axis=-1)
    act = jax.nn.silu(causal_dwconv(gate, conv_w) + conv_b)
    return (act * up) @ w_down


def setup_inputs(seed: int = 0) -> dict:
    key = jax.random.key(seed)
    ks = jax.random.split(key, 16)
    f32 = jnp.float32

    def nrm(k, shape, scale):
        return jax.random.normal(k, shape, f32) * scale

    d_in = D_MODEL ** -0.5
    x = nrm(ks[0], (BATCH, SEQ, D_MODEL), 1.0)
    even_scale = np.ones(EVEN_IN, np.float32)
    even_scale[2 * RET_W:3 * RET_W] = DEEPNORM_BETA
    even_scale[4 * RET_W + 2 * DSA_W:] = DEEPNORM_BETA
    even_w_in = nrm(ks[1], (N_EVEN, D_MODEL, EVEN_IN), d_in) * jnp.asarray(even_scale)
    even_w_out = nrm(ks[2], (N_EVEN, MIX_W_EVEN, D_MODEL), MIX_W_EVEN ** -0.5 * DEEPNORM_BETA)
    rel_bias = nrm(ks[3], (T5_BUCKETS, DSA_HEADS), 0.5)
    odd_scale = np.ones(ODD_IN, np.float32)
    odd_scale[2 * MLSTM_W:3 * MLSTM_W] = DEEPNORM_BETA
    odd_w_in = nrm(ks[4], (N_ODD, D_MODEL, ODD_IN), d_in) * jnp.asarray(odd_scale)
    i_bias = nrm(ks[5], (N_ODD, MLSTM_HEADS), 0.1)
    f_bias = jnp.linspace(3.0, 6.0, MLSTM_HEADS, dtype=f32) + nrm(ks[6], (N_ODD, MLSTM_HEADS), 0.1)
    odd_gate_b = jnp.concatenate([i_bias, f_bias], axis=-1)
    odd_conv_w = nrm(ks[7], (N_ODD, MLSTM_CONV, 2 * MLSTM_W), MLSTM_CONV ** -0.5)
    odd_w_out = nrm(ks[8], (N_ODD, MLSTM_W, D_MODEL), MLSTM_W ** -0.5 * DEEPNORM_BETA)
    ffn_w_up = nrm(ks[9], (DEPTH, D_MODEL, 2 * D_FF), d_in * DEEPNORM_BETA)
    ffn_conv_w = nrm(ks[10], (DEPTH, FFN_CONV, D_FF), FFN_CONV ** -0.5)
    ffn_conv_b = nrm(ks[11], (DEPTH, D_FF), 0.02)
    ffn_w_down = nrm(ks[12], (DEPTH, D_FF, D_MODEL), D_FF ** -0.5 * DEEPNORM_BETA)
    ln_g = 1.0 + nrm(ks[13], (DEPTH, 2, D_MODEL), 0.02)
    ln_b = nrm(ks[14], (DEPTH, 2, D_MODEL), 0.02)
    return {"x": x, "even_w_in": even_w_in, "even_w_out": even_w_out, "rel_bias": rel_bias, "odd_w_in": odd_w_in, "odd_gate_b": odd_gate_b, "odd_conv_w": odd_conv_w, "odd_w_out": odd_w_out, "ffn_w_up": ffn_w_up, "ffn_conv_w": ffn_conv_w, "ffn_conv_b": ffn_conv_b, "ffn_w_down": ffn_w_down, "ln_g": ln_g, "ln_b": ln_b}


def reference(x, even_w_in, even_w_out, rel_bias, odd_w_in, odd_gate_b, odd_conv_w, odd_w_out, ffn_w_up, ffn_conv_w, ffn_conv_b, ffn_w_down, ln_g, ln_b):
    for layer in range(DEPTH):
        j = layer // 2
        if layer % 2 == 0:
            mix = even_mixer(x, even_w_in[j], even_w_out[j], rel_bias)
        else:
            mix = odd_mixer(x, odd_w_in[j], odd_gate_b[j], odd_conv_w[j], odd_w_out[j])
        x = layer_norm(DEEPNORM_ALPHA * x + mix, ln_g[layer, 0], ln_b[layer, 0])
        ffn = conv_ffn(x, ffn_w_up[layer], ffn_conv_w[layer], ffn_conv_b[layer], ffn_w_down[layer])
        x = layer_norm(DEEPNORM_ALPHA * x + ffn, ln_g[layer, 1], ln_b[layer, 1])
    return x
```

```cpp
#include <hip/hip_runtime.h>
#include <cmath>
#include <cstdio>
#include <cstdint>

namespace {
constexpr int DM = 1024, NB = 4, S = 4096, FF = 2816;
constexpr int EVEN_IN = 3584, ODD_IN = 4104;
constexpr float LN_EPS = 1e-5f;
constexpr float ALPHA = 1.41421356237309515f;

template <bool TA, bool TB, bool ACC>
__global__ __launch_bounds__(256) void bgemm(const float* __restrict__ A, int lda, long sA1, long sA2,
                                             const float* __restrict__ B, int ldb, long sB1, long sB2,
                                             float* __restrict__ C, int ldc, long sC1, long sC2,
                                             int nz2, int M, int N, int K) {
    __shared__ float As[16][65];
    __shared__ float Bs[16][65];
    const int z = blockIdx.z, z1 = z / nz2, z2 = z % nz2;
    A += z1 * sA1 + z2 * sA2; B += z1 * sB1 + z2 * sB2; C += z1 * sC1 + z2 * sC2;
    const int tid = threadIdx.x, tx = tid & 15, ty = tid >> 4;
    const int m0 = blockIdx.y * 64, n0 = blockIdx.x * 64;
    float acc[4][4];
#pragma unroll
    for (int i = 0; i < 4; ++i)
#pragma unroll
        for (int j = 0; j < 4; ++j) acc[i][j] = 0.f;
    for (int k0 = 0; k0 < K; k0 += 16) {
#pragma unroll
        for (int r = 0; r < 4; ++r) {
            const int idx = tid + r * 256;
            if (!TA) { const int m = idx >> 4, k = idx & 15; As[k][m] = (m0 + m < M) ? A[(size_t)(m0 + m) * lda + k0 + k] : 0.f; }
            else     { const int k = idx >> 6, m = idx & 63; As[k][m] = (m0 + m < M) ? A[(size_t)(k0 + k) * lda + m0 + m] : 0.f; }
            if (!TB) { const int k = idx >> 6, n = idx & 63; Bs[k][n] = (n0 + n < N) ? B[(size_t)(k0 + k) * ldb + n0 + n] : 0.f; }
            else     { const int n = idx >> 4, k = idx & 15; Bs[k][n] = (n0 + n < N) ? B[(size_t)(n0 + n) * ldb + k0 + k] : 0.f; }
        }
        __syncthreads();
#pragma unroll
        for (int k = 0; k < 16; ++k) {
            float a[4], b[4];
#pragma unroll
            for (int i = 0; i < 4; ++i) { a[i] = As[k][ty * 4 + i]; b[i] = Bs[k][tx * 4 + i]; }
#pragma unroll
            for (int i = 0; i < 4; ++i)
#pragma unroll
                for (int j = 0; j < 4; ++j) acc[i][j] = fmaf(a[i], b[j], acc[i][j]);
        }
        __syncthreads();
    }
#pragma unroll
    for (int i = 0; i < 4; ++i)
#pragma unroll
        for (int j = 0; j < 4; ++j) {
            const int m = m0 + ty * 4 + i, n = n0 + tx * 4 + j;
            if (m < M && n < N) { float* p = C + (size_t)m * ldc + n; *p = ACC ? (*p + acc[i][j]) : acc[i][j]; }
        }
}

__device__ __forceinline__ float wave_sum(float v) {
#pragma unroll
    for (int o = 1; o < 64; o <<= 1) v += __shfl_xor(v, o);
    return v;
}
__device__ __forceinline__ float silu_f(float x) { return x / (1.f + expf(-x)); }
__device__ __forceinline__ float sigmoid_f(float x) { return 1.f / (1.f + expf(-x)); }
__device__ __forceinline__ float log_sigmoid_f(float x) { return fminf(x, 0.f) - log1pf(expf(-fabsf(x))); }

__global__ __launch_bounds__(256) void ln_kernel(const float* xres, const float* mix, const float* g, const float* b, float* out) {
    __shared__ float red[8];
    const int row = blockIdx.x, tid = threadIdx.x;
    const float4 xv = *(const float4*)(xres + (size_t)row * DM + tid * 4);
    const float4 mv = *(const float4*)(mix + (size_t)row * DM + tid * 4);
    float z0 = ALPHA * xv.x + mv.x, z1 = ALPHA * xv.y + mv.y, z2 = ALPHA * xv.z + mv.z, z3 = ALPHA * xv.w + mv.w;
    float s = wave_sum((z0 + z1) + (z2 + z3));
    if ((tid & 63) == 0) red[tid >> 6] = s;
    __syncthreads();
    const float mean = (red[0] + red[1] + red[2] + red[3]) * (1.f / DM);
    z0 -= mean; z1 -= mean; z2 -= mean; z3 -= mean;
    float q = wave_sum((z0 * z0 + z1 * z1) + (z2 * z2 + z3 * z3));
    if ((tid & 63) == 0) red[4 + (tid >> 6)] = q;
    __syncthreads();
    const float var = (red[4] + red[5] + red[6] + red[7]) * (1.f / DM);
    const float rstd = 1.f / sqrtf(var + LN_EPS);
    const float4 gv = *(const float4*)(g + tid * 4), bv = *(const float4*)(b + tid * 4);
    float4 o; o.x = z0 * rstd * gv.x + bv.x; o.y = z1 * rstd * gv.y + bv.y; o.z = z2 * rstd * gv.z + bv.z; o.w = z3 * rstd * gv.w + bv.w;
    *(float4*)(out + (size_t)row * DM + tid * 4) = o;
}

__device__ __forceinline__ float ret_lg(int h) { return log1pf(-exp2f(-5.f - (float)h)); }

__global__ void rot_kernel(const float* h0, float* qr, float* kr, float* qw, float* kw) {
    const int gid = blockIdx.x * blockDim.x + threadIdx.x;
    const int i = gid & 63, hh = (gid >> 6) & 3, t = gid >> 8;
    if (t >= S) return;
    const double inv = pow(10000.0, -(double)(2 * i) / 128.0);
    const double ang = (double)t * inv;
    const float cs = (float)cos(ang), sn = (float)sin(ang);
    const float* row = h0 + (size_t)t * EVEN_IN;
    const int c1 = hh * 128 + i, c2 = c1 + 64;
    const int c = t & 127; const float lg = ret_lg(hh);
    const float gq = expf(lg * (float)(c + 1)), gk = expf(lg * (float)(127 - c));
    { const float x1 = row[c1], x2 = row[c2]; const float o1 = x1 * cs - x2 * sn, o2 = x1 * sn + x2 * cs;
      qr[(size_t)t * 512 + c1] = o1; qr[(size_t)t * 512 + c2] = o2; qw[(size_t)t * 512 + c1] = o1 * gq; qw[(size_t)t * 512 + c2] = o2 * gq; }
    { const float sc = 0.08838834764831845f;
      const float x1 = row[512 + c1], x2 = row[512 + c2]; const float o1 = (x1 * cs - x2 * sn) * sc, o2 = (x1 * sn + x2 * cs) * sc;
      kr[(size_t)t * 512 + c1] = o1; kr[(size_t)t * 512 + c2] = o2; kw[(size_t)t * 512 + c1] = o1 * gk; kw[(size_t)t * 512 + c2] = o2 * gk; }
}
__global__ void ret_scan(float* kv) {
    const int gid = blockIdx.x * blockDim.x + threadIdx.x;
    const int h = gid >> 14, ie = gid & 16383;
    if (h >= 4) return;
    const float cd = expf(ret_lg(h) * 128.f);
    float R = 0.f;
    for (int n = 0; n < 32; ++n) { float* p = kv + ((size_t)(h * 32 + n) << 14) + ie; const float tmp = *p; *p = R; R = cd * R + tmp; }
}
__global__ void ret_mask(float* Sb) {
    const int gid = blockIdx.x * blockDim.x + threadIdx.x;
    const int s = gid & 127, c = (gid >> 7) & 127, h = gid >> 19;
    if (h >= 4) return;
    Sb[gid] = (c >= s) ? Sb[gid] * expf(ret_lg(h) * (float)(c - s)) : 0.f;
}
__global__ __launch_bounds__(256) void ret_norm_gate(const float* yr, const float* h0, float* ymix) {
    const int w = blockIdx.x * 4 + (threadIdx.x >> 6), lane = threadIdx.x & 63;
    const int t = w >> 2, h = w & 3;
    if (t >= S) return;
    const float* p = yr + (size_t)t * 512 + h * 128;
    float a = p[lane], b = p[lane + 64];
    const float mean = wave_sum(a + b) * (1.f / 128.f);
    a -= mean; b -= mean;
    const float var = wave_sum(a * a + b * b) * (1.f / 128.f);
    const float rstd = 1.f / sqrtf(var + LN_EPS);
    const float* g = h0 + (size_t)t * EVEN_IN + 1536 + h * 128;
    ymix[(size_t)t * DM + h * 128 + lane] = a * rstd * silu_f(g[lane]);
    ymix[(size_t)t * DM + h * 128 + lane + 64] = b * rstd * silu_f(g[lane + 64]);
}

__device__ __forceinline__ int t5_bucket(int n) {
    if (n < 16) return n;
    const int th[16] = {16, 22, 30, 40, 54, 73, 99, 134, 182, 246, 332, 450, 609, 825, 1117, 1513};
    int b = 16;
#pragma unroll
    for (int k = 1; k < 16; ++k) b += (n >= th[k]) ? 1 : 0;
    return b;
}
__global__ void bias_tab_kernel(const float* rel_bias, float* btab) {
    const int gid = blockIdx.x * blockDim.x + threadIdx.x;
    if (gid >= 3 * 129 * 8) return;
    const int h = gid & 7, j = (gid >> 3) % 129, br = gid / (129 * 8);
    const int r = br == 0 ? 1 : (br == 1 ? 4 : 16);
    btab[gid] = rel_bias[t5_bucket(j * r) * 8 + h];
}
__global__ __launch_bounds__(256) void dsa_kernel(const float* h0, const float* btab, float* ymix) {
    const int gid = blockIdx.x * 256 + threadIdx.x;
    const int h = gid & 7, t = gid >> 3;
    if (t >= S) return;
    const float* qp = h0 + (size_t)t * EVEN_IN + 2048 + h * 64;
    float q[64], acc[64];
#pragma unroll
    for (int i = 0; i < 64; ++i) { q[i] = qp[i] * 0.125f; acc[i] = 0.f; }
    float m = -INFINITY, ssum = 0.f;
    for (int br = 0; br < 3; ++br) {
        const int r = br == 0 ? 1 : (br == 1 ? 4 : 16);
        const int lq = t / r; const int jmax = lq < 128 ? lq : 128;
        for (int j = 0; j <= jmax; ++j) {
            const int tk = t - j * r;
            const float* kp = h0 + (size_t)tk * EVEN_IN + 2560 + h * 64;
            const float* vp = h0 + (size_t)tk * EVEN_IN + 3072 + h * 64;
            float d0 = 0.f, d1 = 0.f, d2 = 0.f, d3 = 0.f;
#pragma unroll
            for (int i = 0; i < 64; i += 4) { const float4 kv = *(const float4*)(kp + i); d0 = fmaf(q[i], kv.x, d0); d1 = fmaf(q[i + 1], kv.y, d1); d2 = fmaf(q[i + 2], kv.z, d2); d3 = fmaf(q[i + 3], kv.w, d3); }
            const float logit = (d0 + d1) + (d2 + d3) + btab[(br * 129 + j) * 8 + h];
            const float mn = fmaxf(m, logit);
            const float sc = expf(m - mn), p = expf(logit - mn);
            ssum = ssum * sc + p; m = mn;
#pragma unroll
            for (int i = 0; i < 64; i += 4) { const float4 vv = *(const float4*)(vp + i);
                acc[i] = fmaf(p, vv.x, acc[i] * sc); acc[i + 1] = fmaf(p, vv.y, acc[i + 1] * sc); acc[i + 2] = fmaf(p, vv.z, acc[i + 2] * sc); acc[i + 3] = fmaf(p, vv.w, acc[i + 3] * sc); }
        }
    }
    const float inv = 1.f / ssum;
    float* op = ymix + (size_t)t * DM + 512 + h * 64;
#pragma unroll
    for (int i = 0; i < 64; ++i) op[i] = acc[i] * inv;
}

__global__ void ffn_act_kernel(const float* GU, const float* cw, const float* cb, float* H) {
    const size_t gid = (size_t)blockIdx.x * blockDim.x + threadIdx.x;
    if (gid >= (size_t)S * FF) return;
    const int c = (int)(gid % FF), t = (int)(gid / FF);
    float a = cb[c];
#pragma unroll
    for (int k = 0; k < 3; ++k) { const int tt = t - 2 + k; if (tt >= 0) a = fmaf(cw[k * FF + c], GU[(size_t)tt * (2 * FF) + c], a); }
    H[gid] = silu_f(a) * GU[(size_t)t * (2 * FF) + FF + c];
}

__global__ void mconv_kernel(const float* h1, const float* cw, float* qc, float* kc) {
    const size_t gid = (size_t)blockIdx.x * blockDim.x + threadIdx.x;
    if (gid >= (size_t)S * 2048) return;
    const int c = (int)(gid & 2047), t = (int)(gid >> 11);
    float a = 0.f;
#pragma unroll
    for (int k = 0; k < 4; ++k) { const int tt = t - 3 + k; if (tt >= 0) a = fmaf(cw[k * 2048 + c], h1[(size_t)tt * ODD_IN + c], a); }
    const float v = silu_f(a);
    if (c < 1024) qc[(size_t)t * 1024 + c] = v; else kc[(size_t)t * 1024 + c - 1024] = v * 0.0625f;
}
__global__ __launch_bounds__(128) void mgate_kernel(const float* h1, const float* gate_b, float* a_out, float* li_out, float* ew_out, float* g_out, float* mloc_out) {
    __shared__ float lf[128], as[128], ws[128];
    const int n = blockIdx.x & 31, h = blockIdx.x >> 5, s = threadIdx.x, t = n * 128 + s;
    const float gi = h1[(size_t)t * ODD_IN + 4096 + h] + gate_b[h];
    const float gf = h1[(size_t)t * ODD_IN + 4096 + 4 + h] + gate_b[4 + h];
    lf[s] = log_sigmoid_f(gf);
    __syncthreads();
    if (s == 0) { float c = 0.f; for (int i = 0; i < 128; ++i) { c += lf[i]; as[i] = c; } }
    __syncthreads();
    const float g = as[127];
    const float w = g - as[s] + gi;
    ws[s] = w;
    __syncthreads();
    float mx = -INFINITY;
    for (int i = 0; i < 128; ++i) mx = fmaxf(mx, ws[i]);
    a_out[h * S + t] = as[s]; li_out[h * S + t] = gi; ew_out[h * S + t] = expf(w - mx);
    if (s == 0) { g_out[h * 32 + n] = g; mloc_out[h * 32 + n] = mx; }
}
__global__ void mscale_kernel(const float* src, const float* scale  , float* dst) {
    const size_t gid = (size_t)blockIdx.x * blockDim.x + threadIdx.x;
    if (gid >= (size_t)S * 1024) return;
    const int c = (int)(gid & 1023), t = (int)(gid >> 10);
    dst[gid] = src[gid] * scale[(c >> 8) * S + t];
}
__global__ void mksum_kernel(const float* ke, float* ksum) {
    const int gid = blockIdx.x * blockDim.x + threadIdx.x;
    if (gid >= 4 * 32 * 256) return;
    const int i = gid & 255, n = (gid >> 8) & 31, h = gid >> 13;
    float a = 0.f;
    for (int s = 0; s < 128; ++s) a += ke[(size_t)(n * 128 + s) * 1024 + h * 256 + i];
    ksum[gid] = a;
}
__global__ void mscan_kernel(float* kv, const float* ksum, const float* g, const float* mloc, float* nprev, float* mprev) {
    const int gid = blockIdx.x * blockDim.x + threadIdx.x;
    const int h = gid >> 16, ie = gid & 65535, i = ie >> 8, e = ie & 255;
    if (h >= 4) return;
    float Cs = 0.f, ns = 0.f, ms = 0.f;
    for (int n = 0; n < 32; ++n) {
        const float gn = g[h * 32 + n], mn = mloc[h * 32 + n];
        const float mnew = fmaxf(gn + ms, mn);
        const float aold = expf(gn + ms - mnew), aloc = expf(mn - mnew);
        float* p = kv + ((size_t)(h * 32 + n) << 16) + ie; const float tmp = *p; *p = Cs; Cs = aold * Cs + aloc * tmp;
        if (e == 0) { nprev[(h * 32 + n) * 256 + i] = ns; ns = aold * ns + aloc * ksum[(h * 32 + n) * 256 + i]; }
        if (ie == 0) mprev[h * 32 + n] = ms;
        ms = mnew;
    }
}
__global__ __launch_bounds__(128) void mrow_kernel(float* QK, const float* a, const float* li, const float* mprev, float* m_row, float* winter, float* den) {
    __shared__ float as[128], ls[128];
    const int n = blockIdx.x & 31, h = blockIdx.x >> 5, c = threadIdx.x, t = n * 128 + c;
    as[c] = a[h * S + t]; ls[c] = li[h * S + t];
    __syncthreads();
    float mx = -INFINITY;
    for (int s = 0; s <= c; ++s) mx = fmaxf(mx, as[c] - as[s] + ls[s]);
    const float il = as[c] + mprev[h * 32 + n];
    const float m = fmaxf(il, mx);
    float* row = QK + ((size_t)(h * 32 + n) << 14) + c * 128;
    float d = 0.f;
    for (int s = 0; s < 128; ++s) { float p = 0.f; if (s <= c) p = expf(as[c] - as[s] + ls[s] - m) * row[s]; row[s] = p; d += p; }
    m_row[h * S + t] = m; winter[h * S + t] = expf(il - m); den[h * S + t] = d;
}
__global__ void mden_kernel(const float* qc, const float* nprev, const float* winter, float* den) {
    const int gid = blockIdx.x * blockDim.x + threadIdx.x;
    if (gid >= 4 * S) return;
    const int t = gid & (S - 1), h = gid >> 12, n = t >> 7;
    const float* q = qc + (size_t)t * 1024 + h * 256; const float* np = nprev + (h * 32 + n) * 256;
    float a = 0.f;
    for (int i = 0; i < 256; ++i) a = fmaf(q[i], np[i], a);
    den[gid] += winter[gid] * a;
}
__global__ void mfinal_kernel(const float* num, const float* den, const float* m_row, const float* h1, float* ymix) {
    const size_t gid = (size_t)blockIdx.x * blockDim.x + threadIdx.x;
    if (gid >= (size_t)S * 1024) return;
    const int c = (int)(gid & 1023), t = (int)(gid >> 10), h = c >> 8;
    const float dn = fmaxf(fabsf(den[h * S + t]), expf(-m_row[h * S + t]));
    ymix[gid] = num[gid] / dn * sigmoid_f(h1[(size_t)t * ODD_IN + 3072 + c]);
}
}

#define EW_GRID(n) dim3((unsigned)(((size_t)(n) + 255) / 256)), dim3(256), 0, stream

extern "C" void kernel_launch(void* const* d_in, const int* in_sizes, int n_in, void* d_out, int out_size, void* d_ws, size_t ws_size, hipStream_t stream) {
    const float* x = (const float*)d_in[0];
    const float* even_w_in = (const float*)d_in[1];
    const float* even_w_out = (const float*)d_in[2];
    const float* rel_bias = (const float*)d_in[3];
    const float* odd_w_in = (const float*)d_in[4];
    const float* odd_gate_b = (const float*)d_in[5];
    const float* odd_conv_w = (const float*)d_in[6];
    const float* odd_w_out = (const float*)d_in[7];
    const float* ffn_w_up = (const float*)d_in[8];
    const float* ffn_conv_w = (const float*)d_in[9];
    const float* ffn_conv_b = (const float*)d_in[10];
    const float* ffn_w_down = (const float*)d_in[11];
    const float* ln_g = (const float*)d_in[12];
    const float* ln_b = (const float*)d_in[13];
    float* out = (float*)d_out;
    float* ws = (float*)d_ws;
    size_t off = 0;
    auto take = [&](size_t n) { float* p = ws + off; off += (n + 63) & ~(size_t)63; return p; };
    float* hbuf = take((size_t)S * 2 * FF);
    float* qr = take((size_t)S * 1024);
    float* kr = take((size_t)S * 1024);
    float* aux1 = take((size_t)S * 1024);
    float* aux2 = take((size_t)S * 1024);
    float* kvb = take((size_t)4 * 32 * 65536);
    float* Sb = take((size_t)4 * 32 * 16384);
    float* ymix = take((size_t)S * 1024);
    float* mixout = take((size_t)S * 1024);
    float* btab = take(3 * 129 * 8);
    float* ga = take(4 * S); float* gli = take(4 * S); float* gew = take(4 * S);
    float* gg = take(128); float* gml = take(128); float* gmp = take(128);
    float* ksum = take(4 * 32 * 256); float* nprev = take(4 * 32 * 256);
    float* mrow = take(4 * S); float* wint = take(4 * S); float* den = take(4 * S);
    float* Hact = qr;
    if (off * 4 > ws_size) { fprintf(stderr, "workspace too small: need %zu have %zu\n", off * 4, ws_size); return; }

    bias_tab_kernel<<<EW_GRID(3 * 129 * 8)>>>(rel_bias, btab);

    for (int layer = 0; layer < 2; ++layer) {
        const float* xin_all = (layer == 0) ? x : out;
        for (int b = 0; b < NB; ++b) {
            const float* xb = xin_all + (size_t)b * S * DM;
            float* ob = out + (size_t)b * S * DM;
            if (layer == 0) {
                bgemm<false, false, false><<<dim3(EVEN_IN / 64, S / 64, 1), 256, 0, stream>>>(xb, DM, 0, 0, even_w_in, EVEN_IN, 0, 0, hbuf, EVEN_IN, 0, 0, 1, S, EVEN_IN, DM);
                rot_kernel<<<EW_GRID((size_t)S * 256)>>>(hbuf, qr, kr, aux1  , aux2  );
                bgemm<true, false, false><<<dim3(2, 2, 128), 256, 0, stream>>>(aux2, 512, 128, (long)128 * 512, hbuf + 1024, EVEN_IN, 128, (long)128 * EVEN_IN, kvb, 128, (long)32 * 16384, 16384, 32, 128, 128, 128);
                ret_scan<<<EW_GRID(4 * 16384)>>>(kvb);
                bgemm<false, true, false><<<dim3(2, 2, 128), 256, 0, stream>>>(qr, 512, 128, (long)128 * 512, kr, 512, 128, (long)128 * 512, Sb, 128, (long)32 * 16384, 16384, 32, 128, 128, 128);
                ret_mask<<<EW_GRID((size_t)4 * 32 * 16384)>>>(Sb);
                float* yr = mixout;
                bgemm<false, false, false><<<dim3(2, 2, 128), 256, 0, stream>>>(Sb, 128, (long)32 * 16384, 16384, hbuf + 1024, EVEN_IN, 128, (long)128 * EVEN_IN, yr, 512, 128, (long)128 * 512, 32, 128, 128, 128);
                bgemm<false, false, true><<<dim3(2, 2, 128), 256, 0, stream>>>(aux1, 512, 128, (long)128 * 512, kvb, 128, (long)32 * 16384, 16384, yr, 512, 128, (long)128 * 512, 32, 128, 128, 128);
                ret_norm_gate<<<dim3(S), 256, 0, stream>>>(yr, hbuf, ymix);
                dsa_kernel<<<dim3(S * 8 / 256), 256, 0, stream>>>(hbuf, btab, ymix);
                bgemm<false, false, false><<<dim3(DM / 64, S / 64, 1), 256, 0, stream>>>(ymix, DM, 0, 0, even_w_out, DM, 0, 0, mixout, DM, 0, 0, 1, S, DM, DM);
            } else {
                bgemm<false, false, false><<<dim3((ODD_IN + 63) / 64, S / 64, 1), 256, 0, stream>>>(xb, DM, 0, 0, odd_w_in, ODD_IN, 0, 0, hbuf, ODD_IN, 0, 0, 1, S, ODD_IN, DM);
                mconv_kernel<<<EW_GRID((size_t)S * 2048)>>>(hbuf, odd_conv_w, qr, kr);
                mgate_kernel<<<dim3(128), 128, 0, stream>>>(hbuf, odd_gate_b, ga, gli, gew, gg, gml);
                mscale_kernel<<<EW_GRID((size_t)S * 1024)>>>(kr, gew, aux2);
                bgemm<true, false, false><<<dim3(4, 4, 128), 256, 0, stream>>>(aux2, 1024, 256, (long)128 * 1024, hbuf + 2048, ODD_IN, 256, (long)128 * ODD_IN, kvb, 256, (long)32 * 65536, 65536, 32, 256, 256, 128);
                mksum_kernel<<<EW_GRID(4 * 32 * 256)>>>(aux2, ksum);
                mscan_kernel<<<EW_GRID(4 * 65536)>>>(kvb, ksum, gg, gml, nprev, gmp);
                bgemm<false, true, false><<<dim3(2, 2, 128), 256, 0, stream>>>(qr, 1024, 256, (long)128 * 1024, kr, 1024, 256, (long)128 * 1024, Sb, 128, (long)32 * 16384, 16384, 32, 128, 128, 256);
                mrow_kernel<<<dim3(128), 128, 0, stream>>>(Sb, ga, gli, gmp, mrow, wint, den);
                bgemm<false, false, false><<<dim3(4, 2, 128), 256, 0, stream>>>(Sb, 128, (long)32 * 16384, 16384, hbuf + 2048, ODD_IN, 256, (long)128 * ODD_IN, aux1, 1024, 256, (long)128 * 1024, 32, 128, 256, 128);
                mden_kernel<<<EW_GRID(4 * S)>>>(qr, nprev, wint, den);
                mscale_kernel<<<EW_GRID((size_t)S * 1024)>>>(qr, wint, aux2);
                bgemm<false, false, true><<<dim3(4, 2, 128), 256, 0, stream>>>(aux2, 1024, 256, (long)128 * 1024, kvb, 256, (long)32 * 65536, 65536, aux1, 1024, 256, (long)128 * 1024, 32, 128, 256, 256);
                mfinal_kernel<<<EW_GRID((size_t)S * 1024)>>>(aux1, den, mrow, hbuf, ymix);
                bgemm<false, false, false><<<dim3(DM / 64, S / 64, 1), 256, 0, stream>>>(ymix, DM, 0, 0, odd_w_out, DM, 0, 0, mixout, DM, 0, 0, 1, S, DM, DM);
            }
            ln_kernel<<<dim3(S), 256, 0, stream>>>(xb, mixout, ln_g + (layer * 2 + 0) * DM, ln_b + (layer * 2 + 0) * DM, ob);
            bgemm<false, false, false><<<dim3(2 * FF / 64, S / 64, 1), 256, 0, stream>>>(ob, DM, 0, 0, ffn_w_up + (size_t)layer * DM * 2 * FF, 2 * FF, 0, 0, hbuf, 2 * FF, 0, 0, 1, S, 2 * FF, DM);
            ffn_act_kernel<<<EW_GRID((size_t)S * FF)>>>(hbuf, ffn_conv_w + (size_t)layer * 3 * FF, ffn_conv_b + (size_t)layer * FF, Hact);
            bgemm<false, false, false><<<dim3(DM / 64, S / 64, 1), 256, 0, stream>>>(Hact, FF, 0, 0, ffn_w_down + (size_t)layer * FF * DM, DM, 0, 0, mixout, DM, 0, 0, 1, S, DM, FF);
            ln_kernel<<<dim3(S), 256, 0, stream>>>(ob, mixout, ln_g + (layer * 2 + 1) * DM, ln_b + (layer * 2 + 1) * DM, ob);
        }
    }
}
```

```cpp
#include <hip/hip_runtime.h>
#include <hip/hip_cooperative_groups.h>
#include <cmath>
#include <cstdio>
#include <cstdint>
namespace cg = cooperative_groups;

#define LAS __attribute__((address_space(3)))
#define GAS __attribute__((address_space(1)))
typedef unsigned short bf16_t;
typedef short bf16x8 __attribute__((ext_vector_type(8)));
typedef float f32x4 __attribute__((ext_vector_type(4)));
typedef float f32x2 __attribute__((ext_vector_type(2)));
typedef unsigned u32x4 __attribute__((ext_vector_type(4)));
typedef unsigned u32x2 __attribute__((ext_vector_type(2)));

constexpr int DM = 1024, NB = 4, SEQ = 4096, M = NB * SEQ, FF = 2816;
constexpr int EVEN_IN = 3584, ODD_IN = 4104, ODD_N = 4096;
constexpr float LN_EPS = 1e-5f;
constexpr float ALPHA = 1.41421356237309515f;
constexpr int NWAVES = 8, NTHR = 512;

constexpr size_t MiB = 1u << 20;
constexpr size_t WS_CTL = 0, CTL_ZERO_BYTES = 1 * MiB;
constexpr size_t WS_TAB = 1 * MiB;
constexpr size_t WS_W1 = 5 * MiB;
constexpr size_t WS_XB = 5 * MiB + 27 * MiB - MiB / 2;
constexpr size_t WS_W0 = WS_XB + 32 * MiB;
constexpr size_t WS_R = WS_W0 + 26 * MiB - MiB / 2;
constexpr size_t WS_END = 256 * MiB;
constexpr size_t T_COS = WS_TAB, T_SIN = T_COS + MiB, T_BTAB = T_SIN + MiB;
constexpr size_t T_GATES = T_BTAB + 16384;
constexpr size_t T_SMALL = T_GATES + 512 * 1024;
constexpr size_t W1_IN = WS_W1, W1_OUT = W1_IN + 8 * MiB, W1_UP = W1_OUT + 2 * MiB, W1_DOWN = W1_UP + 11 * MiB;
constexpr size_t W0_IN = WS_W0, W0_OUT = W0_IN + 7 * MiB, W0_UP = W0_OUT + 2 * MiB, W0_DOWN = W0_UP + 11 * MiB;
static_assert(W1_DOWN + 5 * MiB + MiB / 2 <= WS_XB && W0_DOWN + 5 * MiB + MiB / 2 <= WS_R, "weights map");
constexpr size_t L0_H = WS_R, L0_SCR = WS_R + 112 * MiB;
constexpr size_t L1_H = WS_W0, L1_SCR = WS_W0 + 128 * MiB;
static_assert(L1_SCR + 64 * MiB <= WS_END && L0_SCR + 32 * MiB <= WS_END, "scratch map");
constexpr size_t F_H = WS_R, F_MIX = WS_R + 88 * MiB, F_GST = 233 * MiB, F_UST = F_GST + 11 * MiB;
static_assert(F_MIX + 64 * MiB <= WS_END && F_UST + 6 * MiB <= WS_END, "ffn map");
constexpr size_t L0_MIX = WS_R, L1_MIX = L1_SCR;
constexpr size_t L1_ST4 = L1_SCR;

constexpr int RING_BYTES = 131072, LDSCTL_OFF = RING_BYTES, MISC_OFF = LDSCTL_OFF + 320, LDS_BYTES = 147456;

__device__ __forceinline__ unsigned f2bf(float f) { unsigned u = __builtin_bit_cast(unsigned, f); return (u + 0x7fffu + ((u >> 16) & 1u)) >> 16; }
__device__ __forceinline__ unsigned pk2(float lo, float hi) { return f2bf(lo) | (f2bf(hi) << 16); }
__device__ __forceinline__ float bf2f(unsigned short b) { return __builtin_bit_cast(float, (unsigned)b << 16); }
__device__ __forceinline__ float bflo(unsigned w) { return __builtin_bit_cast(float, w << 16); }
__device__ __forceinline__ float bfhi(unsigned w) { return __builtin_bit_cast(float, w & 0xffff0000u); }
__device__ __forceinline__ unsigned cvt_pk_bf16(float lo, float hi) { unsigned r; asm volatile("v_cvt_pk_bf16_f32 %0, %1, %2" : "=v"(r) : "v"(lo), "v"(hi)); return r; }
__device__ __forceinline__ float wave_sum(float v) {
#pragma unroll
    for (int o = 1; o < 64; o <<= 1) v += __shfl_xor(v, o);
    return v;
}
__device__ __forceinline__ float silu_f(float x) { return x / (1.f + __expf(-x)); }
__device__ __forceinline__ float silu_acc(float x) { return x / (1.f + expf(-x)); }
__device__ __forceinline__ float sigmoid_f(float x) { return 1.f / (1.f + expf(-x)); }
__device__ __forceinline__ float log_sigmoid_f(float x) { return fminf(x, 0.f) - log1pf(expf(-fabsf(x))); }
__device__ __forceinline__ float ret_lg(int h) { return log1pf(-exp2f(-5.f - (float)h)); }
template <int CTRL> __device__ __forceinline__ float dpp_mov(float old, float src) {
    return __builtin_bit_cast(float, __builtin_amdgcn_update_dpp(__builtin_bit_cast(int, old), __builtin_bit_cast(int, src), CTRL, 0xF, 0xF, false));
}

namespace pg8 {
constexpr int BM = 256, BK = 64, HALF = 128, HTB = HALF * BK * 2, STAGE_BYTES = 8 * HTB, NXCD = 8, WGM = 8;
__host__ __device__ __forceinline__ int lds_byte(int r, int c) { const int st = (r >> 4) * 2 + (c >> 5), rr = r & 15, cc = c & 31, ob = rr * 64 + cc * 2; return st * 1024 + (ob ^ (((ob >> 9) & 1) << 5)); }
__host__ __device__ __forceinline__ void stage_rc(int b, int& R, int& C) { const int st = b / 1024, sb = b % 1024, swz = sb ^ (((sb >> 9) & 1) << 5); R = (st >> 1) * 16 + swz / 64; C = (st & 1) * 32 + (swz % 64) / 2; }
__host__ __device__ __forceinline__ int perm32(int rho) { const int n = rho >> 4, i = rho & 15; return 8 * (i >> 2) + 4 * n + (i & 3); }
struct Unit { int pm, pn; };
struct Gemm { const bf16_t* A; const bf16_t* Bt; int lda, N, K; };
struct StaticOrder {
    int nM, nN, nwg, G, c;
    __device__ void init(int Mr, int N, int G_, int c_) { nM = Mr / BM; nN = N / BM; nwg = nM * nN; G = G_; c = c_; }
    __device__ bool next(int i, Unit& u) const {
        const long L = (long)i * G + c; if (L >= nwg) return false;
        int wgid = (int)L; { const int q = nwg / NXCD, r = nwg % NXCD, xcd = wgid % NXCD, off = wgid / NXCD; wgid = (xcd < r ? xcd * (q + 1) : r * (q + 1) + (xcd - r) * q) + off; }
        const int nig = WGM * nN, gid = wgid / nig, fm = gid * WGM, gsz = (nM - fm) < WGM ? (nM - fm) : WGM;
        u.pm = fm + ((wgid % nig) % gsz); u.pn = (wgid % nig) / gsz; return true;
    }
};

template <class Epi, bool ALIGN_EPI, bool SINGLE = false>
__device__ __forceinline__ void gemm_phase(LAS unsigned char* lds, const Gemm g, const StaticOrder& S, const Epi& E) {
    int tid_ = threadIdx.x; asm volatile("" : "+v"(tid_));
    const int tid = tid_, wid = __builtin_amdgcn_readfirstlane(tid >> 6), lane = tid & 63, wr = wid >> 2, wc = wid & 3, fr = lane & 15, fq = lane >> 4;
    const int K = g.K, nt = K / BK, lda = g.lda;
    unsigned voffA[2], voffB[2];
#pragma unroll
    for (int i = 0; i < 2; ++i) { int R, C; stage_rc(tid * 16 + i * 8192, R, C); const int Rb = Epi::PERM ? ((R & ~31) + perm32(R & 31)) : R;
        voffA[i] = (unsigned)(R * lda + C) * 2u; voffB[i] = (unsigned)(Rb * K + C) * 2u; }
    const size_t kstep = (size_t)(BK * 2);
    const size_t hstepA = (size_t)HALF * lda * 2, tstepA = 2 * hstepA;
    const size_t hstepB = (size_t)HALF * K * 2, tstepB = 2 * hstepB;
    const unsigned ldsw = (unsigned)wid * 1024u;
    const int aoff = lds_byte(wr * 64 + fr, fq * 8), boff = lds_byte(wc * 32 + fr, fq * 8);
#define PG8_SA(b, h) (((b) * 2 + (h)) * HTB)
#define PG8_SB(b, h) ((4 + (b) * 2 + (h)) * HTB)
#define PG8_STAGE(bufoff, gbase, voff) do { _Pragma("unroll") for (int _i = 0; _i < 2; ++_i) \
        __builtin_amdgcn_global_load_lds((const unsigned*)((const char*)(gbase) + (voff)[_i]), (LAS unsigned*)(lds + (bufoff) + ldsw + _i * 8192), 16, 0, 0); } while (0)
#define PG8_LDA(dst, b, h) do { _Pragma("unroll") for (int m = 0; m < 4; ++m) _Pragma("unroll") for (int k = 0; k < 2; ++k) dst[m][k] = *(const LAS bf16x8*)(lds + PG8_SA(b, h) + aoff + m * 2048 + k * 1024); } while (0)
#define PG8_LDB(dst, b, h) do { _Pragma("unroll") for (int n = 0; n < 2; ++n) _Pragma("unroll") for (int k = 0; k < 2; ++k) dst[n][k] = *(const LAS bf16x8*)(lds + PG8_SB(b, h) + boff + n * 2048 + k * 1024); } while (0)
#define PG8_MMA(ai, bj, At, Bt) do { __builtin_amdgcn_s_setprio(1); _Pragma("unroll") for (int m = 0; m < 4; ++m) _Pragma("unroll") for (int n = 0; n < 2; ++n) _Pragma("unroll") for (int k = 0; k < 2; ++k) \
        acc[ai][bj][m][n] = __builtin_amdgcn_mfma_f32_16x16x32_bf16(Bt[n][k], At[m][k], acc[ai][bj][m][n], 0, 0, 0); __builtin_amdgcn_s_setprio(0); } while (0)
#define PG8_WAIT_V(n) asm volatile("s_waitcnt vmcnt(" #n ")" ::: "memory")
#define PG8_WAIT_L(n) asm volatile("s_waitcnt lgkmcnt(" #n ")" ::: "memory")
#define PG8_BAR __builtin_amdgcn_s_barrier()
#define PG8_SCHED __builtin_amdgcn_sched_barrier(0)
    Unit cur, nxt; int ui = 0;
    if (!S.next(0, cur)) return;
    f32x4 acc[2][2][4][2];
#pragma unroll
    for (int a = 0; a < 2; ++a)
#pragma unroll
        for (int b = 0; b < 2; ++b)
#pragma unroll
            for (int m = 0; m < 4; ++m)
#pragma unroll
                for (int n = 0; n < 2; ++n) acc[a][b][m][n] = (f32x4){0.f, 0.f, 0.f, 0.f};
    bf16x8 At[4][2], B0[2][2], B1[2][2];
    const char* cA = (const char*)g.A + (size_t)cur.pm * tstepA; const char* cB = (const char*)g.Bt + (size_t)cur.pn * tstepB;
    {
        PG8_STAGE(PG8_SB(0, 0), cB, voffB); PG8_STAGE(PG8_SB(0, 1), cB + hstepB, voffB); PG8_STAGE(PG8_SA(0, 0), cA, voffA); PG8_STAGE(PG8_SA(0, 1), cA + hstepA, voffA);
        if (wr == 1) PG8_BAR;
        PG8_WAIT_V(2); PG8_BAR;
        PG8_STAGE(PG8_SB(1, 0), cB + kstep, voffB); PG8_STAGE(PG8_SA(1, 0), cA + kstep, voffA); PG8_STAGE(PG8_SB(1, 1), cB + hstepB + kstep, voffB);
        PG8_WAIT_V(6); PG8_BAR;
    }
    for (;;) {
        const bool has_next = SINGLE ? false : S.next(ui + 1, nxt);
        const char* nA = has_next ? (const char*)g.A + (size_t)nxt.pm * tstepA : cA; const char* nB = has_next ? (const char*)g.Bt + (size_t)nxt.pn * tstepB : cB;
        for (int t = 0; t < nt; t += 2) {
            const bool last = (t == nt - 2);
            const char* a1 = cA + (size_t)(t + 1) * kstep;
            const char* a2 = last ? nA : cA + (size_t)(t + 2) * kstep; const char* b2 = last ? nB : cB + (size_t)(t + 2) * kstep;
            const char* a3 = a2 + kstep; const char* b3 = b2 + kstep;
            PG8_LDB(B0, 0, 0); PG8_LDB(B1, 0, 1); PG8_SCHED; PG8_LDA(At, 0, 0); PG8_STAGE(PG8_SA(1, 1), a1 + hstepA, voffA);
            PG8_WAIT_V(8); PG8_WAIT_L(0); PG8_BAR; PG8_MMA(0, 0, At, B0); PG8_MMA(0, 1, At, B1); PG8_BAR; PG8_SCHED;
            PG8_LDA(At, 0, 1); PG8_STAGE(PG8_SB(0, 0), b2, voffB); PG8_STAGE(PG8_SB(0, 1), b2 + hstepB, voffB); PG8_STAGE(PG8_SA(0, 0), a2, voffA);
            PG8_WAIT_V(8); PG8_WAIT_L(0); PG8_BAR; PG8_MMA(1, 0, At, B0); PG8_MMA(1, 1, At, B1); PG8_BAR; PG8_SCHED;
            PG8_LDB(B0, 1, 0); PG8_LDB(B1, 1, 1); PG8_SCHED; PG8_LDA(At, 1, 0); PG8_STAGE(PG8_SA(0, 1), a2 + hstepA, voffA);
            PG8_WAIT_V(8); PG8_WAIT_L(0); PG8_BAR; PG8_MMA(0, 0, At, B0); PG8_MMA(0, 1, At, B1); PG8_BAR; PG8_SCHED;
            PG8_LDA(At, 1, 1); PG8_STAGE(PG8_SB(1, 0), b3, voffB); PG8_STAGE(PG8_SB(1, 1), b3 + hstepB, voffB); PG8_STAGE(PG8_SA(1, 0), a3, voffA);
            PG8_WAIT_V(8); PG8_WAIT_L(0); PG8_BAR; PG8_MMA(1, 0, At, B0); PG8_MMA(1, 1, At, B1); PG8_BAR; PG8_SCHED;
        }
        if constexpr (ALIGN_EPI) { if (wr == 0) PG8_BAR; }
        { int fr_ = fr, fq_ = fq; asm volatile("" : "+v"(fr_), "+v"(fq_));
          E(acc, cur, wr, wc, fr_, fq_); }
        if (!has_next) break;
#pragma unroll
        for (int a = 0; a < 2; ++a)
#pragma unroll
            for (int b = 0; b < 2; ++b)
#pragma unroll
                for (int m = 0; m < 4; ++m)
#pragma unroll
                    for (int n = 0; n < 2; ++n) acc[a][b][m][n] = (f32x4){0.f, 0.f, 0.f, 0.f};
        cur = nxt; cA = nA; cB = nB; ++ui;
        if constexpr (ALIGN_EPI) { if (wr == 1) PG8_BAR; }
    }
    PG8_WAIT_V(0);
    if constexpr (!ALIGN_EPI) { if (wr == 0) PG8_BAR; }
    PG8_BAR;
#undef PG8_SA
#undef PG8_SB
#undef PG8_STAGE
#undef PG8_LDA
#undef PG8_LDB
#undef PG8_MMA
#undef PG8_WAIT_V
#undef PG8_WAIT_L
#undef PG8_BAR
#undef PG8_SCHED
}

struct EpiF32 {
    static constexpr bool PERM = false;
    float* C; int ldc;
    __device__ __forceinline__ void operator()(const f32x4 (&acc)[2][2][4][2], const Unit& u, int wr, int wc, int fr, int fq) const {
        const int row0 = u.pm * BM + wr * 64 + fr, col0 = u.pn * BM + wc * 32 + 4 * fq;
#pragma unroll
        for (int ai = 0; ai < 2; ++ai)
#pragma unroll
            for (int m = 0; m < 4; ++m) { float* rowp = C + (size_t)(row0 + ai * HALF + m * 16) * ldc + col0;
#pragma unroll
                for (int bj = 0; bj < 2; ++bj)
#pragma unroll
                    for (int n = 0; n < 2; ++n) *(f32x4*)(rowp + bj * HALF + n * 16) = acc[ai][bj][m][n]; }
    }
};
struct EpiH0 {
    static constexpr bool PERM = true;
    bf16_t* O; const float* cs; const float* sn;
    __device__ __forceinline__ void operator()(const f32x4 (&acc)[2][2][4][2], const Unit& u, int wr, int wc, int fr, int fq) const {
        const int row0 = u.pm * BM + wr * 64 + fr;
        if (u.pn < 4) {
            const int cc = wc * 32 + 8 * fq;
            const int head = 2 * (u.pn & 1) + (cc >> 6), i0 = cc & 63;
            const float sc = (u.pn >= 2) ? 0.08838834764831845f : 1.f;
            bf16_t* base = O + (u.pn >= 2 ? 512 : 0) + head * 128 + i0;
#pragma unroll
            for (int ai = 0; ai < 2; ++ai)
#pragma unroll
                for (int m = 0; m < 4; ++m) {
                    const int row = row0 + ai * HALF + m * 16, pos = row & (SEQ - 1);
                    const f32x4 c0 = *(const f32x4*)(cs + pos * 64 + i0), c1 = *(const f32x4*)(cs + pos * 64 + i0 + 4);
                    const f32x4 s0 = *(const f32x4*)(sn + pos * 64 + i0), s1 = *(const f32x4*)(sn + pos * 64 + i0 + 4);
                    const f32x4 a0 = acc[ai][0][m][0], a1 = acc[ai][0][m][1], b0 = acc[ai][1][m][0], b1 = acc[ai][1][m][1];
                    const f32x4 o10 = (a0 * c0 - b0 * s0) * sc, o11 = (a1 * c1 - b1 * s1) * sc, o20 = (a0 * s0 + b0 * c0) * sc, o21 = (a1 * s1 + b1 * c1) * sc;
                    u32x4 w1, w2;
                    w1.x = cvt_pk_bf16(o10[0], o10[1]); w1.y = cvt_pk_bf16(o10[2], o10[3]); w1.z = cvt_pk_bf16(o11[0], o11[1]); w1.w = cvt_pk_bf16(o11[2], o11[3]);
                    w2.x = cvt_pk_bf16(o20[0], o20[1]); w2.y = cvt_pk_bf16(o20[2], o20[3]); w2.z = cvt_pk_bf16(o21[0], o21[1]); w2.w = cvt_pk_bf16(o21[2], o21[3]);
                    bf16_t* rp = base + (size_t)row * EVEN_IN;
                    *(u32x4*)rp = w1; *(u32x4*)(rp + 64) = w2;
                }
        } else {
            const int col0 = u.pn * BM + wc * 32 + 8 * fq;
#pragma unroll
            for (int ai = 0; ai < 2; ++ai)
#pragma unroll
                for (int m = 0; m < 4; ++m) { bf16_t* rowp = O + (size_t)(row0 + ai * HALF + m * 16) * EVEN_IN + col0;
#pragma unroll
                    for (int bj = 0; bj < 2; ++bj) { const f32x4 v0 = acc[ai][bj][m][0], v1 = acc[ai][bj][m][1]; u32x4 w;
                        w.x = cvt_pk_bf16(v0[0], v0[1]); w.y = cvt_pk_bf16(v0[2], v0[3]); w.z = cvt_pk_bf16(v1[0], v1[1]); w.w = cvt_pk_bf16(v1[2], v1[3]);
                        *(u32x4*)(rowp + bj * HALF) = w; } }
        }
    }
};
struct EpiFfn {
    static constexpr bool PERM = true;
    bf16_t* H; const float* cw; const float* cb; float* gst; float* ust;
    __device__ __forceinline__ void operator()(const f32x4 (&acc)[2][2][4][2], const Unit& u, int wr, int wc, int fr, int fq) const {
        const int ch0 = u.pn * 128 + wc * 32 + 8 * fq;
#pragma unroll
        for (int ai = 0; ai < 2; ++ai) {
            const int blk = u.pm * 4 + ai * 2 + wr, rowb = blk * 64;
            unsigned ow[4][4];
#pragma unroll
            for (int n = 0; n < 2; ++n) {
                const f32x4 w0 = *(const f32x4*)(cw + ch0 + 4 * n), w1 = *(const f32x4*)(cw + FF + ch0 + 4 * n), w2 = *(const f32x4*)(cw + 2 * FF + ch0 + 4 * n), bb = *(const f32x4*)(cb + ch0 + 4 * n);
                float hv[4][4];
#pragma unroll
                for (int j = 0; j < 4; ++j) {
#pragma unroll
                    for (int m = 0; m < 4; ++m) {
                        const float g = acc[ai][0][m][n][j];
                        float p1, p2;
                        if (m == 0) { p1 = dpp_mov<0x111>(0.f, g); p2 = dpp_mov<0x112>(0.f, g); }
                        else { const float gp = acc[ai][0][m - 1][n][j]; p1 = dpp_mov<0x111>(dpp_mov<0x121>(0.f, gp), g); p2 = dpp_mov<0x112>(dpp_mov<0x122>(0.f, gp), g); }
                        const float cv = fmaf(w0[j], p2, fmaf(w1[j], p1, fmaf(w2[j], g, bb[j])));
                        hv[m][j] = silu_f(cv) * acc[ai][1][m][n][j];
                    }
                }
#pragma unroll
                for (int m = 0; m < 4; ++m) { ow[m][2 * n] = cvt_pk_bf16(hv[m][0], hv[m][1]); ow[m][2 * n + 1] = cvt_pk_bf16(hv[m][2], hv[m][3]); }
                if (fr >= 14) *(f32x4*)(gst + ((size_t)blk * 4 + (fr - 14)) * FF + ch0 + 4 * n) = acc[ai][0][3][n];
                if (fr < 2) { *(f32x4*)(gst + ((size_t)blk * 4 + 2 + fr) * FF + ch0 + 4 * n) = acc[ai][0][0][n]; *(f32x4*)(ust + ((size_t)blk * 2 + fr) * FF + ch0 + 4 * n) = acc[ai][1][0][n]; }
            }
#pragma unroll
            for (int m = 0; m < 4; ++m) if (m > 0 || fr >= 2) { u32x4 w; w.x = ow[m][0]; w.y = ow[m][1]; w.z = ow[m][2]; w.w = ow[m][3]; *(u32x4*)(H + (size_t)(rowb + m * 16 + fr) * FF + ch0) = w; }
        }
    }
};
struct EpiH1 {
    static constexpr bool PERM = true;
    bf16_t* O; const float* cw; float* st4;
    __device__ __forceinline__ void operator()(const f32x4 (&acc)[2][2][4][2], const Unit& u, int wr, int wc, int fr, int fq) const {
        if (u.pn < 8) {
            const float osc = (u.pn >= 4) ? 0.0625f : 1.f;
#pragma unroll
            for (int ai = 0; ai < 2; ++ai) {
                const int blk = u.pm * 4 + ai * 2 + wr, rowb = blk * 64;
#pragma unroll
                for (int bj = 0; bj < 2; ++bj) {
                    const int ch0 = u.pn * 256 + bj * 128 + wc * 32 + 8 * fq;
                    unsigned ow[4][4];
#pragma unroll
                    for (int n = 0; n < 2; ++n) {
                        const f32x4 w0 = *(const f32x4*)(cw + ch0 + 4 * n), w1 = *(const f32x4*)(cw + 2048 + ch0 + 4 * n), w2 = *(const f32x4*)(cw + 4096 + ch0 + 4 * n), w3 = *(const f32x4*)(cw + 6144 + ch0 + 4 * n);
                        float hv[4][4];
#pragma unroll
                        for (int j = 0; j < 4; ++j) {
#pragma unroll
                            for (int m = 0; m < 4; ++m) {
                                const float g = acc[ai][bj][m][n][j];
                                float p1, p2, p3;
                                if (m == 0) { p1 = dpp_mov<0x111>(0.f, g); p2 = dpp_mov<0x112>(0.f, g); p3 = dpp_mov<0x113>(0.f, g); }
                                else { const float gp = acc[ai][bj][m - 1][n][j]; p1 = dpp_mov<0x111>(dpp_mov<0x121>(0.f, gp), g); p2 = dpp_mov<0x112>(dpp_mov<0x122>(0.f, gp), g); p3 = dpp_mov<0x113>(dpp_mov<0x123>(0.f, gp), g); }
                                const float cv = fmaf(w0[j], p3, fmaf(w1[j], p2, fmaf(w2[j], p1, w3[j] * g)));
                                hv[m][j] = silu_f(cv) * osc;
                            }
                        }
#pragma unroll
                        for (int m = 0; m < 4; ++m) { ow[m][2 * n] = cvt_pk_bf16(hv[m][0], hv[m][1]); ow[m][2 * n + 1] = cvt_pk_bf16(hv[m][2], hv[m][3]); }
                        if (fr >= 13) *(f32x4*)(st4 + ((size_t)blk * 6 + (fr - 13)) * 2048 + ch0 + 4 * n) = acc[ai][bj][3][n];
                        if (fr < 3) *(f32x4*)(st4 + ((size_t)blk * 6 + 3 + fr) * 2048 + ch0 + 4 * n) = acc[ai][bj][0][n];
                    }
#pragma unroll
                    for (int m = 0; m < 4; ++m) if (m > 0 || fr >= 3) { u32x4 w; w.x = ow[m][0]; w.y = ow[m][1]; w.z = ow[m][2]; w.w = ow[m][3]; *(u32x4*)(O + (size_t)(rowb + m * 16 + fr) * ODD_N + ch0) = w; }
                }
            }
        } else {
            const int row0 = u.pm * BM + wr * 64 + fr, col0 = u.pn * BM + wc * 32 + 8 * fq;
#pragma unroll
            for (int ai = 0; ai < 2; ++ai)
#pragma unroll
                for (int m = 0; m < 4; ++m) { bf16_t* rowp = O + (size_t)(row0 + ai * HALF + m * 16) * ODD_N + col0;
#pragma unroll
                    for (int bj = 0; bj < 2; ++bj) { const f32x4 v0 = acc[ai][bj][m][0], v1 = acc[ai][bj][m][1]; u32x4 w;
                        w.x = cvt_pk_bf16(v0[0], v0[1]); w.y = cvt_pk_bf16(v0[2], v0[3]); w.z = cvt_pk_bf16(v1[0], v1[1]); w.w = cvt_pk_bf16(v1[2], v1[3]);
                        *(u32x4*)(rowp + bj * HALF) = w; } }
        }
    }
};
}

#define XB_TMO      128
#define XB_XCNT(j)  (256  + 64 * (j))
#define XB_XSUB(j)  (1280 + 64 * (j))
#define XB_XGEN(j)  (2304 + 64 * (j))
#define XB_TOP      3328
#define XB_TOPGEN   3392
#define XCD_BAR_WORDS 3456
#define XB_SPIN_CAP (1u << 20)
__device__ __forceinline__ unsigned xb_ld(unsigned* p)              { return __hip_atomic_load(p, __ATOMIC_RELAXED, __HIP_MEMORY_SCOPE_AGENT); }
__device__ __forceinline__ unsigned xb_add(unsigned* p, unsigned v) { return __hip_atomic_fetch_add(p, v, __ATOMIC_RELAXED, __HIP_MEMORY_SCOPE_AGENT); }
__device__ __forceinline__ unsigned xb_xcc_id() { return (unsigned)__builtin_amdgcn_s_getreg((3 << 11) | 20) & 0xFu; }
#define XB_SPIN(cond, bar) do { unsigned _sp = 0; while (cond) { __builtin_amdgcn_s_sleep(1); \
    if ((++_sp & 255u) == 0u) { if (xb_ld(&(bar)[XB_TMO])) break; if (_sp > XB_SPIN_CAP) { atomicAdd(&(bar)[XB_TMO], 1u); break; } } } } while (0)
struct XcdBarrier { unsigned* bar; unsigned x; volatile LAS unsigned* st; };
__device__ __forceinline__ XcdBarrier xcd_barrier_post(unsigned* bar, volatile LAS unsigned* st) {
    XcdBarrier b; b.bar = bar; b.x = xb_xcc_id(); b.st = st;
    if (threadIdx.x == 0) (void)xb_add(&bar[XB_XCNT(b.x)], 1u);
    return b;
}
__device__ __forceinline__ void xcd_barrier_complete(unsigned* bar, unsigned x, unsigned& nloc, unsigned& nx) {
    const unsigned G = gridDim.x * gridDim.y * gridDim.z;
    unsigned sum, cnt, mine, sp = 0u;
    for (;;) {
        sum = 0u; cnt = 0u; mine = 0u;
#pragma unroll
        for (unsigned j = 0; j < 16; ++j) { const unsigned c = xb_ld(&bar[XB_XCNT(j)]); sum += c; cnt += (c > 0u) ? 1u : 0u; mine = (j == x) ? c : mine; }
        if (sum == G) break;
        __builtin_amdgcn_s_sleep(1);
        if ((++sp & 255u) == 0u) { if (xb_ld(&bar[XB_TMO])) break; if (sp > XB_SPIN_CAP) { atomicAdd(&bar[XB_TMO], 1u); break; } }
    }
    nloc = mine > 0u ? mine : 1u; nx = cnt > 0u ? cnt : 1u;
}
__device__ __forceinline__ void xcd_barrier(const XcdBarrier& b) {
    asm volatile("s_waitcnt vmcnt(0)" ::: "memory");
    __syncthreads();
    if (threadIdx.x == 0) {
        unsigned* bar = b.bar;
        __builtin_amdgcn_s_waitcnt(0);
        unsigned nloc = b.st[0], nx = b.st[1];
        if (nloc == 0u) { xcd_barrier_complete(bar, b.x, nloc, nx); b.st[0] = nloc; b.st[1] = nx; }
        const unsigned old = xb_add(&bar[XB_XSUB(b.x)], 1u);
        const unsigned gen = old / nloc;
        if (old + 1u == (gen + 1u) * nloc) {
            __builtin_amdgcn_fence(__ATOMIC_RELEASE, "agent");
            asm volatile("s_waitcnt vmcnt(0)" ::: "memory");
            const unsigned og = xb_add(&bar[XB_TOP], 1u);
            const unsigned tg = og / nx;
            if (og + 1u == (tg + 1u) * nx) xb_add(&bar[XB_TOPGEN], 1u);
            else XB_SPIN(xb_ld(&bar[XB_TOPGEN]) == tg, bar);
            __builtin_amdgcn_fence(__ATOMIC_ACQUIRE, "agent");
            xb_add(&bar[XB_XGEN(b.x)], 1u);
            asm volatile("s_waitcnt vmcnt(0)" ::: "memory");
        } else {
            XB_SPIN(xb_ld(&bar[XB_XGEN(b.x)]) == gen, bar);
            __builtin_amdgcn_fence(__ATOMIC_ACQUIRE, "agent");
            asm volatile("s_waitcnt vmcnt(0)" ::: "memory");
        }
    }
    __syncthreads();
}

__device__ __forceinline__ int fresh_tid() { int t = threadIdx.x; asm volatile("" : "+v"(t)); return t; }
struct Args { const float* in[14]; float* out; unsigned char* ws; };
struct Frame {
    LAS unsigned char* lds; int wave, vcu, G; unsigned char* ws; float* out;
    __device__ __forceinline__ int ftid() const { return fresh_tid(); }
};
#define GRID_STRIDE(i, n) for (size_t i = (size_t)blockIdx.x * NTHR + fresh_tid(); i < (size_t)(n); i += (size_t)gridDim.x * NTHR)

__device__ __forceinline__ void p0_transpose_item(const float* W, int K, int ldw, bf16_t* WT, int k0, int n0, int dst_row0, LAS float* scr, int lane) {
#pragma unroll 8
    for (int i = 0; i < 32; ++i) { const int kk = 2 * i + (lane >> 5); scr[kk * 33 + (lane & 31)] = W[(size_t)(k0 + kk) * ldw + n0 + (lane & 31)]; }
    asm volatile("s_waitcnt lgkmcnt(0)" ::: "memory");
    const int c = lane & 7;
#pragma unroll
    for (int j = 0; j < 4; ++j) { const int n = (lane >> 3) + 8 * j; const LAS float* s = scr + (8 * c) * 33 + n;
        u32x4 o; o.x = pk2(s[0 * 33], s[1 * 33]); o.y = pk2(s[2 * 33], s[3 * 33]); o.z = pk2(s[4 * 33], s[5 * 33]); o.w = pk2(s[6 * 33], s[7 * 33]);
        *(u32x4*)(WT + (size_t)(dst_row0 + n) * K + k0 + 8 * c) = o; }
    asm volatile("s_waitcnt lgkmcnt(0)" ::: "memory");
}
__device__ __forceinline__ int map_even_in(int c) {
    if (c >= 1024) return c;
    const int blk = c >> 9, cc = c & 511, head = cc >> 7, i128 = cc & 127, half = i128 >> 6, i = i128 & 63;
    return 256 * (blk * 2 + (head >> 1)) + 128 * half + 64 * (head & 1) + i;
}
__device__ __forceinline__ int map_up(int c) { if (c < FF) return 256 * (c >> 7) + (c & 127); const int ch = c - FF; return 256 * (ch >> 7) + 128 + (ch & 127); }
__device__ __forceinline__ int map_id(int c) { return c; }

template <int MAP>
__device__ __forceinline__ void p0_weight(const Frame& F, const float* W, int K, int ldw, int Ncols, bf16_t* WT) {
    LAS float* scr = (LAS float*)(F.lds + F.wave * 16384);
    const int gw = F.vcu * NWAVES + F.wave, NGW = F.G * NWAVES;
    const int nblk = Ncols / 32, nitems = (K / 64) * nblk; const int lane = F.ftid() & 63;
    for (int it = gw; it < nitems; it += NGW) {
        const int kb = it / nblk, nb = it % nblk, n0 = nb * 32;
        const int d0 = MAP == 1 ? map_even_in(n0) : (MAP == 2 ? map_up(n0) : n0);
        p0_transpose_item(W, K, ldw, WT, kb * 64, n0, d0, scr, lane);
    }
}
__device__ __forceinline__ int t5_bucket(int n) {
    if (n < 16) return n;
    int b = 16;
    b += (n >= 22); b += (n >= 30); b += (n >= 40); b += (n >= 54); b += (n >= 73); b += (n >= 99); b += (n >= 134); b += (n >= 182);
    b += (n >= 246); b += (n >= 332); b += (n >= 450); b += (n >= 609); b += (n >= 825); b += (n >= 1117); b += (n >= 1513);
    return b;
}
__device__ const double INV_TAB[64] = {1.0, 0.8659643233600653, 0.7498942093324559, 0.6493816315762113, 0.5623413251903491, 0.4869675251658631, 0.4216965034285822, 0.3651741272548377, 0.31622776601683794, 0.27384196342643613, 0.23713737056616552, 0.2053525026457146, 0.1778279410038923, 0.1539926526059492, 0.1333521432163324, 0.11547819846894582, 0.1, 0.08659643233600653, 0.07498942093324558, 0.06493816315762113, 0.05623413251903491, 0.04869675251658631, 0.042169650342858224, 0.03651741272548377, 0.03162277660168379, 0.027384196342643614, 0.023713737056616554, 0.02053525026457146, 0.01778279410038923, 0.01539926526059492, 0.01333521432163324, 0.011547819846894581, 0.01, 0.008659643233600654, 0.007498942093324558, 0.006493816315762113, 0.005623413251903491, 0.004869675251658631, 0.004216965034285823, 0.003651741272548377, 0.0031622776601683794, 0.0027384196342643613, 0.0023713737056616554, 0.002053525026457146, 0.0017782794100389228, 0.001539926526059492, 0.001333521432163324, 0.0011547819846894581, 0.001, 0.0008659643233600654, 0.0007498942093324559, 0.0006493816315762113, 0.0005623413251903491, 0.0004869675251658631, 0.00042169650342858224, 0.0003651741272548377, 0.00031622776601683794, 0.0002738419634264361, 0.00023713737056616554, 0.0002053525026457146, 0.00017782794100389227, 0.0001539926526059492, 0.0001333521432163324, 0.00011547819846894582};
__device__ __forceinline__ void p0_prologue(const Frame& F, const Args& a) {
    unsigned char* ws = F.ws;
    p0_weight<1>(F, a.in[1], DM, EVEN_IN, EVEN_IN, (bf16_t*)(ws + W0_IN));
    p0_weight<0>(F, a.in[2], DM, DM, DM, (bf16_t*)(ws + W0_OUT));
    p0_weight<0>(F, a.in[4], DM, ODD_IN, ODD_N, (bf16_t*)(ws + W1_IN));
    p0_weight<0>(F, a.in[7], DM, DM, DM, (bf16_t*)(ws + W1_OUT));
    p0_weight<2>(F, a.in[8], DM, 2 * FF, 2 * FF, (bf16_t*)(ws + W0_UP));
    p0_weight<2>(F, a.in[8] + (size_t)DM * 2 * FF, DM, 2 * FF, 2 * FF, (bf16_t*)(ws + W1_UP));
    p0_weight<0>(F, a.in[11], FF, DM, DM, (bf16_t*)(ws + W0_DOWN));
    p0_weight<0>(F, a.in[11] + (size_t)FF * DM, FF, DM, DM, (bf16_t*)(ws + W1_DOWN));
    { const float* x = a.in[0]; bf16_t* xb = (bf16_t*)(ws + WS_XB);
      GRID_STRIDE(i, (size_t)M * DM / 8) { const f32x4 v0 = *(const f32x4*)(x + i * 8), v1 = *(const f32x4*)(x + i * 8 + 4); u32x4 o; o.x = pk2(v0[0], v0[1]); o.y = pk2(v0[2], v0[3]); o.z = pk2(v1[0], v1[1]); o.w = pk2(v1[2], v1[3]); *(u32x4*)(xb + i * 8) = o; } }
    { float* cs = (float*)(ws + T_COS); float* sn = (float*)(ws + T_SIN);
      GRID_STRIDE(i, (size_t)SEQ * 64) { const int ii = (int)(i & 63), t = (int)(i >> 6); const double ang = (double)t * INV_TAB[ii];
          const double kk = __builtin_rint(ang * 0.15915494309189535); const double r = __builtin_fma(-kk, 6.283185307179586, ang) - kk * 2.4492935982947064e-16;
          const float rf = (float)r; cs[i] = cosf(rf); sn[i] = sinf(rf); } }
    { float* bt = (float*)(ws + T_BTAB); const float* rb = a.in[3];
      GRID_STRIDE(i, 3 * 129 * 8) { const int h = (int)(i & 7), j = (int)((i >> 3) % 129), br = (int)(i / (129 * 8)); const int r = br == 0 ? 1 : (br == 1 ? 4 : 16); bt[i] = rb[t5_bucket(j * r) * 8 + h]; } }
}

template <bool WRITE_BF16, bool GATES>
__device__ __forceinline__ void ln_phase(const Frame& F, const float* xres, const float* mix, const float* g, const float* b, float* outp, bf16_t* xb, const float* w_in1, float* gates) {
    const int gw = F.vcu * NWAVES + F.wave, NGW = F.G * NWAVES;
    LAS float* wg = (LAS float*)F.lds;
    const int tid = F.ftid(), lane = tid & 63;
    if (GATES) { for (int i = tid; i < DM * 8; i += NTHR) wg[i] = w_in1[(size_t)(i >> 3) * ODD_IN + ODD_N + (i & 7)]; __syncthreads(); }
    for (int m = gw; m < M; m += NGW) {
        const f32x4* xr = (const f32x4*)(xres + (size_t)m * DM) + lane; const f32x4* mr = (const f32x4*)(mix + (size_t)m * DM) + lane;
        f32x4 v[4]; float s = 0.f;
#pragma unroll
        for (int j = 0; j < 4; ++j) { v[j] = xr[64 * j] * ALPHA + mr[64 * j]; s += (v[j][0] + v[j][1]) + (v[j][2] + v[j][3]); }
        const float mean = wave_sum(s) * (1.f / DM); float s2 = 0.f;
#pragma unroll
        for (int j = 0; j < 4; ++j) { v[j] = v[j] - mean; s2 += (v[j][0] * v[j][0] + v[j][1] * v[j][1]) + (v[j][2] * v[j][2] + v[j][3] * v[j][3]); }
        const float rstd = 1.f / sqrtf(wave_sum(s2) * (1.f / DM) + LN_EPS);
        float ga[8];
        if (GATES) {
#pragma unroll
            for (int q = 0; q < 8; ++q) ga[q] = 0.f;
        }
#pragma unroll
        for (int j = 0; j < 4; ++j) {
            const f32x4 gv = *((const f32x4*)g + lane + 64 * j), bv = *((const f32x4*)b + lane + 64 * j);
            const f32x4 o = v[j] * rstd * gv + bv;
            *((f32x4*)(outp + (size_t)m * DM) + lane + 64 * j) = o;
            if (WRITE_BF16) { u32x2 w; w.x = pk2(o[0], o[1]); w.y = pk2(o[2], o[3]); *((u32x2*)(xb + (size_t)m * DM) + lane + 64 * j) = w; }
            if (GATES) {
#pragma unroll
                for (int e = 0; e < 4; ++e) { const int k = (lane + 64 * j) * 4 + e; const f32x4 wa = *(const LAS f32x4*)(wg + k * 8), wb = *(const LAS f32x4*)(wg + k * 8 + 4);
                    ga[0] = fmaf(o[e], wa[0], ga[0]); ga[1] = fmaf(o[e], wa[1], ga[1]); ga[2] = fmaf(o[e], wa[2], ga[2]); ga[3] = fmaf(o[e], wa[3], ga[3]);
                    ga[4] = fmaf(o[e], wb[0], ga[4]); ga[5] = fmaf(o[e], wb[1], ga[5]); ga[6] = fmaf(o[e], wb[2], ga[6]); ga[7] = fmaf(o[e], wb[3], ga[7]); }
            }
        }
        if (GATES) {
#pragma unroll
            for (int q = 0; q < 8; ++q) ga[q] = wave_sum(ga[q]);
            if (lane == 0) { *(f32x4*)(gates + (size_t)m * 8) = (f32x4){ga[0], ga[1], ga[2], ga[3]}; *(f32x4*)(gates + (size_t)m * 8 + 4) = (f32x4){ga[4], ga[5], ga[6], ga[7]}; }
        }
    }
    if (GATES) __syncthreads();
}

__device__ __forceinline__ void ffn_fix_phase(const float* gst, const float* ust, const float* cw, const float* cb, bf16_t* H) {
    GRID_STRIDE(i, (size_t)256 * 2 * FF) {
        const int ch = (int)(i % FF), r = (int)((i / FF) & 1), blk = (int)(i / (2 * FF));
        const bool first = ((blk * 64) & (SEQ - 1)) == 0;
        float a = cb[ch];
#pragma unroll
        for (int k = 0; k < 3; ++k) { const int idx = r + k; float g;
            if (idx < 2) g = first ? 0.f : gst[((size_t)(blk - 1) * 4 + idx) * FF + ch]; else g = gst[((size_t)blk * 4 + idx) * FF + ch];
            a = fmaf(cw[k * FF + ch], g, a); }
        H[(size_t)(blk * 64 + r) * FF + ch] = (bf16_t)f2bf(silu_f(a) * ust[((size_t)blk * 2 + r) * FF + ch]);
    }
}
__device__ __forceinline__ void qk_fix_phase(const float* st4, const float* cw, bf16_t* O) {
    GRID_STRIDE(i, (size_t)256 * 3 * 2048) {
        const int ch = (int)(i & 2047), r = (int)((i >> 11) % 3), blk = (int)(i / (3 * 2048));
        const bool first = ((blk * 64) & (SEQ - 1)) == 0;
        float a = 0.f;
#pragma unroll
        for (int k = 0; k < 4; ++k) { const int idx = r + k; float g;
            if (idx < 3) g = first ? 0.f : st4[((size_t)(blk - 1) * 6 + idx) * 2048 + ch]; else g = st4[((size_t)blk * 6 + idx) * 2048 + ch];
            a = fmaf(cw[k * 2048 + ch], g, a); }
        O[(size_t)(blk * 64 + r) * ODD_N + ch] = (bf16_t)f2bf(silu_f(a) * (ch >= 1024 ? 0.0625f : 1.f));
    }
}

template <class T> __device__ __forceinline__ float ldv(const T* p);
template <> __device__ __forceinline__ float ldv<float>(const float* p) { return *p; }
template <> __device__ __forceinline__ float ldv<bf16_t>(const bf16_t* p) { return bf2f(*p); }
template <bool TA, bool TB, bool ACC, class TAe, class TBe>
__device__ __forceinline__ void bgemm_phase(const Frame& F, const TAe* A, int lda, long sA1, long sA2, const float* rsA, long sR1, long sR2,
                                            const TBe* B, int ldb, long sB1, long sB2, float* C, int ldc, long sC1, long sC2, int nz, int nz2, int Mt, int N, int K) {
    LAS float* As = (LAS float*)F.lds;
    LAS float* Bs = As + 16 * 129;
    const int tid = F.ftid(), tx = tid & 15, ty = tid >> 4;
    const int tM = Mt / 128, tN = N / 64, ntile = tM * tN * nz;
    for (int vt = blockIdx.x; vt < ntile; vt += gridDim.x) {
        const int z = vt / (tM * tN), rem = vt % (tM * tN), m0 = (rem / tN) * 128, n0 = (rem % tN) * 64;
        const int z1 = z / nz2, z2 = z % nz2;
        const TAe* Az = A + z1 * sA1 + z2 * sA2; const TBe* Bz = B + z1 * sB1 + z2 * sB2; float* Cz = C + z1 * sC1 + z2 * sC2;
        const float* rs = rsA ? rsA + z1 * sR1 + z2 * sR2 : nullptr;
        float acc[4][4];
#pragma unroll
        for (int i = 0; i < 4; ++i)
#pragma unroll
            for (int j = 0; j < 4; ++j) acc[i][j] = 0.f;
        for (int k0 = 0; k0 < K; k0 += 16) {
#pragma unroll
            for (int r = 0; r < 4; ++r) {
                const int idx = tid + r * 512;
                if (!TA) { const int m = idx >> 4, k = idx & 15; float v = ldv(Az + (size_t)(m0 + m) * lda + k0 + k); if (rs) v *= rs[m0 + m]; As[k * 129 + m] = v; }
                else     { const int k = idx >> 7, m = idx & 127; float v = ldv(Az + (size_t)(k0 + k) * lda + m0 + m); if (rs) v *= rs[k0 + k]; As[k * 129 + m] = v; }
            }
#pragma unroll
            for (int r = 0; r < 2; ++r) {
                const int idx = tid + r * 512;
                if (!TB) { const int k = idx >> 6, n = idx & 63; Bs[k * 65 + n] = ldv(Bz + (size_t)(k0 + k) * ldb + n0 + n); }
                else     { const int n = idx >> 4, k = idx & 15; Bs[k * 65 + n] = ldv(Bz + (size_t)(n0 + n) * ldb + k0 + k); }
            }
            __syncthreads();
#pragma unroll
            for (int k = 0; k < 16; ++k) {
                float av[4], bv[4];
#pragma unroll
                for (int i = 0; i < 4; ++i) { av[i] = As[k * 129 + ty * 4 + i]; bv[i] = Bs[k * 65 + tx * 4 + i]; }
#pragma unroll
                for (int i = 0; i < 4; ++i)
#pragma unroll
                    for (int j = 0; j < 4; ++j) acc[i][j] = fmaf(av[i], bv[j], acc[i][j]);
            }
            __syncthreads();
        }
#pragma unroll
        for (int i = 0; i < 4; ++i)
#pragma unroll
            for (int j = 0; j < 4; ++j) { float* p = Cz + (size_t)(m0 + ty * 4 + i) * ldc + n0 + tx * 4 + j; *p = ACC ? (*p + acc[i][j]) : acc[i][j]; }
    }
}

__device__ __forceinline__ void dsa_naive_phase(const bf16_t* h0  , const float* btab, bf16_t* ymix  ) {
    GRID_STRIDE(gid, (size_t)SEQ * 8) {
        const int h = (int)(gid & 7), t = (int)(gid >> 3);
        const bf16_t* qp = h0 + (size_t)t * EVEN_IN + 2048 + h * 64;
        float q[64], acc[64];
#pragma unroll
        for (int i = 0; i < 64; i += 8) { const u32x4 w = *(const u32x4*)(qp + i);
            q[i] = bflo(w.x) * 0.125f; q[i + 1] = bfhi(w.x) * 0.125f; q[i + 2] = bflo(w.y) * 0.125f; q[i + 3] = bfhi(w.y) * 0.125f;
            q[i + 4] = bflo(w.z) * 0.125f; q[i + 5] = bfhi(w.z) * 0.125f; q[i + 6] = bflo(w.w) * 0.125f; q[i + 7] = bfhi(w.w) * 0.125f; }
#pragma unroll
        for (int i = 0; i < 64; ++i) acc[i] = 0.f;
        float m = -INFINITY, ssum = 0.f;
        for (int br = 0; br < 3; ++br) {
            const int r = br == 0 ? 1 : (br == 1 ? 4 : 16);
            const int lq = t / r; const int jmax = lq < 128 ? lq : 128;
            for (int j = 0; j <= jmax; ++j) {
                const int tk = t - j * r;
                const bf16_t* kp = h0 + (size_t)tk * EVEN_IN + 2560 + h * 64;
                const bf16_t* vp = h0 + (size_t)tk * EVEN_IN + 3072 + h * 64;
                float d0 = 0.f, d1 = 0.f;
#pragma unroll
                for (int i = 0; i < 64; i += 8) { const u32x4 w = *(const u32x4*)(kp + i);
                    d0 = fmaf(q[i], bflo(w.x), d0); d1 = fmaf(q[i + 1], bfhi(w.x), d1); d0 = fmaf(q[i + 2], bflo(w.y), d0); d1 = fmaf(q[i + 3], bfhi(w.y), d1);
                    d0 = fmaf(q[i + 4], bflo(w.z), d0); d1 = fmaf(q[i + 5], bfhi(w.z), d1); d0 = fmaf(q[i + 6], bflo(w.w), d0); d1 = fmaf(q[i + 7], bfhi(w.w), d1); }
                const float logit = d0 + d1 + btab[(br * 129 + j) * 8 + h];
                const float mn = fmaxf(m, logit);
                const float sc = expf(m - mn), p = expf(logit - mn);
                ssum = ssum * sc + p; m = mn;
#pragma unroll
                for (int i = 0; i < 64; i += 8) { const u32x4 w = *(const u32x4*)(vp + i);
                    acc[i] = fmaf(p, bflo(w.x), acc[i] * sc); acc[i + 1] = fmaf(p, bfhi(w.x), acc[i + 1] * sc); acc[i + 2] = fmaf(p, bflo(w.y), acc[i + 2] * sc); acc[i + 3] = fmaf(p, bfhi(w.y), acc[i + 3] * sc);
                    acc[i + 4] = fmaf(p, bflo(w.z), acc[i + 4] * sc); acc[i + 5] = fmaf(p, bfhi(w.z), acc[i + 5] * sc); acc[i + 6] = fmaf(p, bflo(w.w), acc[i + 6] * sc); acc[i + 7] = fmaf(p, bfhi(w.w), acc[i + 7] * sc); }
            }
        }
        const float inv = 1.f / ssum;
        bf16_t* op = ymix + (size_t)t * DM + 512 + h * 64;
#pragma unroll
        for (int i = 0; i < 64; i += 8) { u32x4 w; w.x = pk2(acc[i] * inv, acc[i + 1] * inv); w.y = pk2(acc[i + 2] * inv, acc[i + 3] * inv); w.z = pk2(acc[i + 4] * inv, acc[i + 5] * inv); w.w = pk2(acc[i + 6] * inv, acc[i + 7] * inv); *(u32x4*)(op + i) = w; }
    }
}

#define GRID_BAR() xcd_barrier(bar)
template <int layer>
__device__ __forceinline__ void run_layer(const Frame& F, const Args& args, const XcdBarrier& bar) {
    unsigned char* ws = F.ws; float* out = F.out; const float* x_in = args.in[0];
    const float* ln_g = args.in[12]; const float* ln_b = args.in[13];
    bf16_t* XB = (bf16_t*)(ws + WS_XB); LAS unsigned char* ring = F.lds;
        const float* xres = (layer == 0) ? x_in : out;
        float* mixo;
        if (layer == 0) {
            { pg8::Gemm g{XB, (const bf16_t*)(ws + W0_IN), DM, EVEN_IN, DM}; pg8::StaticOrder S; S.init(M, EVEN_IN, F.G, (int)blockIdx.x);
              pg8::EpiH0 E{(bf16_t*)(ws + L0_H), (const float*)(ws + T_COS), (const float*)(ws + T_SIN)};
              pg8::gemm_phase<pg8::EpiH0, true>(ring, g, S, E); }
            GRID_BAR();
            const bf16_t* h0 = (const bf16_t*)(ws + L0_H);
            float* kvb = (float*)(ws + L0_SCR); float* Sb = kvb + (size_t)4 * 32 * 16384; float* yr = Sb + (size_t)4 * 32 * 16384;
            float* kwt = (float*)(ws + T_SMALL); float* qwt = kwt + 512;
            GRID_STRIDE(i, 512) { const int h = (int)(i >> 7), c = (int)(i & 127); const float lg = ret_lg(h); kwt[i] = expf(lg * (float)(127 - c)); qwt[i] = expf(lg * (float)(c + 1)); }
            GRID_BAR();
            for (int b = 0; b < NB; ++b) {
                const bf16_t* hb = h0 + (size_t)b * SEQ * EVEN_IN; bf16_t* yb = XB + (size_t)b * SEQ * DM;
                bgemm_phase<true, false, false, bf16_t, bf16_t>(F, hb + 512, EVEN_IN, 128, (long)128 * EVEN_IN, kwt, 128, 0, hb + 1024, EVEN_IN, 128, (long)128 * EVEN_IN, kvb, 128, (long)32 * 16384, 16384, 128, 32, 128, 128, 128);
                dsa_naive_phase(hb, (const float*)(ws + T_BTAB), yb);
                GRID_BAR();
                GRID_STRIDE(gid, 4 * 16384) { const int h = (int)(gid >> 14), ie = (int)(gid & 16383); const float cd = expf(ret_lg(h) * 128.f); float R = 0.f;
                    for (int n = 0; n < 32; ++n) { float* p = kvb + ((size_t)(h * 32 + n) << 14) + ie; const float tmp = *p; *p = R; R = cd * R + tmp; } }
                bgemm_phase<false, true, false, bf16_t, bf16_t>(F, hb, EVEN_IN, 128, (long)128 * EVEN_IN, nullptr, 0, 0, hb + 512, EVEN_IN, 128, (long)128 * EVEN_IN, Sb, 128, (long)32 * 16384, 16384, 128, 32, 128, 128, 128);
                GRID_BAR();
                GRID_STRIDE(gid, (size_t)4 * 32 * 16384) { const int s = (int)(gid & 127), c = (int)((gid >> 7) & 127), h = (int)(gid >> 19); Sb[gid] = (c >= s) ? Sb[gid] * expf(ret_lg(h) * (float)(c - s)) : 0.f; }
                GRID_BAR();
                bgemm_phase<false, false, false, float, bf16_t>(F, Sb, 128, (long)32 * 16384, 16384, nullptr, 0, 0, hb + 1024, EVEN_IN, 128, (long)128 * EVEN_IN, yr, 512, 128, (long)128 * 512, 128, 32, 128, 128, 128);
                GRID_BAR();
                bgemm_phase<false, false, true, bf16_t, float>(F, hb, EVEN_IN, 128, (long)128 * EVEN_IN, qwt, 128, 0, kvb, 128, (long)32 * 16384, 16384, yr, 512, 128, (long)128 * 512, 128, 32, 128, 128, 128);
                GRID_BAR();
                { const int gw = F.vcu * NWAVES + F.wave, NGW = F.G * NWAVES; const int lane = F.ftid() & 63;
                  for (int w = gw; w < SEQ * 4; w += NGW) { const int t = w >> 2, h = w & 3; const float* p = yr + (size_t)t * 512 + h * 128;
                      float a0 = p[lane], a1 = p[lane + 64]; const float mean = wave_sum(a0 + a1) * (1.f / 128.f); a0 -= mean; a1 -= mean;
                      const float var = wave_sum(a0 * a0 + a1 * a1) * (1.f / 128.f); const float rstd = 1.f / sqrtf(var + LN_EPS);
                      const bf16_t* gp = hb + (size_t)t * EVEN_IN + 1536 + h * 128;
                      yb[(size_t)t * DM + h * 128 + lane] = (bf16_t)f2bf(a0 * rstd * silu_acc(bf2f(gp[lane])));
                      yb[(size_t)t * DM + h * 128 + lane + 64] = (bf16_t)f2bf(a1 * rstd * silu_acc(bf2f(gp[lane + 64]))); } }
                GRID_BAR();
            }
            mixo = (float*)(ws + L0_MIX);
            { pg8::Gemm g{XB, (const bf16_t*)(ws + W0_OUT), DM, DM, DM}; pg8::StaticOrder S; S.init(M, DM, F.G, (int)blockIdx.x);
              pg8::EpiF32 E{mixo, DM}; pg8::gemm_phase<pg8::EpiF32, false, true>(ring, g, S, E); }
            GRID_BAR();
        } else {
            { pg8::Gemm g{XB, (const bf16_t*)(ws + W1_IN), DM, ODD_N, DM}; pg8::StaticOrder S; S.init(M, ODD_N, F.G, (int)blockIdx.x);
              pg8::EpiH1 E{(bf16_t*)(ws + L1_H), args.in[6], (float*)(ws + L1_ST4)};
              pg8::gemm_phase<pg8::EpiH1, true>(ring, g, S, E); }
            GRID_BAR();
            qk_fix_phase((const float*)(ws + L1_ST4), args.in[6], (bf16_t*)(ws + L1_H));
            GRID_BAR();
            const bf16_t* h1 = (const bf16_t*)(ws + L1_H);
            const float* gates = (const float*)(ws + T_GATES); const float* gate_b = args.in[5];
            float* kvb = (float*)(ws + L1_SCR); float* Sb = kvb + (size_t)4 * 32 * 65536; float* num = Sb + (size_t)4 * 32 * 16384;
            float* sm = (float*)(ws + L1_SCR + 56 * MiB);
            for (int b = 0; b < NB; ++b) {
                float* ga = sm + (size_t)b * 196608; float* gli = ga + 4 * SEQ; float* gew = gli + 4 * SEQ; float* mrow = gew + 4 * SEQ; float* wint = mrow + 4 * SEQ; float* den = wint + 4 * SEQ;
                float* gg = den + 4 * SEQ; float* gml = gg + 128; float* gmp = gml + 128; float* ksum = gmp + 128; float* nprev = ksum + 32768;
                const bf16_t* hb = h1 + (size_t)b * SEQ * ODD_N; bf16_t* yb = XB + (size_t)b * SEQ * DM;
                const float* gb = gates + (size_t)b * SEQ * 8;
                { LAS float* lf = (LAS float*)F.lds; LAS float* as = lf + 512; LAS float* wsx = as + 512;
                  for (int it0 = blockIdx.x * 4; it0 < 128; it0 += gridDim.x * 4) {
                      const int tid = F.ftid(); const int grp = tid >> 7, s = tid & 127, item = it0 + grp; const bool ok = item < 128;
                      const int n = item & 31, h = (item >> 5) & 3, t = n * 128 + s;
                      float gi = 0.f;
                      if (ok) { gi = gb[(size_t)t * 8 + h] + gate_b[h]; const float gf = gb[(size_t)t * 8 + 4 + h] + gate_b[4 + h]; lf[grp * 128 + s] = log_sigmoid_f(gf); }
                      __syncthreads();
                      if (ok && s == 0) { float c = 0.f; for (int i = 0; i < 128; ++i) { c += lf[grp * 128 + i]; as[grp * 128 + i] = c; } }
                      __syncthreads();
                      float w = 0.f, gv = 0.f;
                      if (ok) { gv = as[grp * 128 + 127]; w = gv - as[grp * 128 + s] + gi; wsx[grp * 128 + s] = w; }
                      __syncthreads();
                      if (ok) { float mx = -INFINITY; for (int i = 0; i < 128; ++i) mx = fmaxf(mx, wsx[grp * 128 + i]);
                          ga[h * SEQ + t] = as[grp * 128 + s]; gli[h * SEQ + t] = gi; gew[h * SEQ + t] = expf(w - mx);
                          if (s == 0) { gg[h * 32 + n] = gv; gml[h * 32 + n] = mx; } }
                      __syncthreads();
                  } }
                GRID_BAR();
                bgemm_phase<true, false, false, bf16_t, bf16_t>(F, hb + 1024, ODD_N, 256, (long)128 * ODD_N, gew, SEQ, 128, hb + 2048, ODD_N, 256, (long)128 * ODD_N, kvb, 256, (long)32 * 65536, 65536, 128, 32, 256, 256, 128);
                GRID_STRIDE(gid, 4 * 32 * 256) { const int i = (int)(gid & 255), n = (int)((gid >> 8) & 31), h = (int)(gid >> 13); float a = 0.f;
                    for (int s = 0; s < 128; ++s) a += bf2f(hb[(size_t)(n * 128 + s) * ODD_N + 1024 + h * 256 + i]) * gew[h * SEQ + n * 128 + s];
                    ksum[gid] = a; }
                bgemm_phase<false, true, false, bf16_t, bf16_t>(F, hb, ODD_N, 256, (long)128 * ODD_N, nullptr, 0, 0, hb + 1024, ODD_N, 256, (long)128 * ODD_N, Sb, 128, (long)32 * 16384, 16384, 128, 32, 128, 128, 256);
                GRID_BAR();
                GRID_STRIDE(gid, 4 * 65536) { const int h = (int)(gid >> 16), ie = (int)(gid & 65535), i = ie >> 8, e = ie & 255; float Cs = 0.f, ns = 0.f, ms = 0.f;
                    for (int n = 0; n < 32; ++n) { const float gn = gg[h * 32 + n], mn = gml[h * 32 + n]; const float mnew = fmaxf(gn + ms, mn); const float aold = expf(gn + ms - mnew), aloc = expf(mn - mnew);
                        float* p = kvb + ((size_t)(h * 32 + n) << 16) + ie; const float tmp = *p; *p = Cs; Cs = aold * Cs + aloc * tmp;
                        if (e == 0) { nprev[(h * 32 + n) * 256 + i] = ns; ns = aold * ns + aloc * ksum[(h * 32 + n) * 256 + i]; }
                        if (ie == 0) gmp[h * 32 + n] = ms;
                        ms = mnew; } }
                GRID_BAR();
                { LAS float* as = (LAS float*)F.lds; LAS float* ls = as + 512;
                  for (int it0 = blockIdx.x * 4; it0 < 128; it0 += gridDim.x * 4) {
                      const int tid = F.ftid(); const int grp = tid >> 7, c = tid & 127, item = it0 + grp; const bool ok = item < 128;
                      const int n = item & 31, h = (item >> 5) & 3, t = n * 128 + c;
                      if (ok) { as[grp * 128 + c] = ga[h * SEQ + t]; ls[grp * 128 + c] = gli[h * SEQ + t]; }
                      __syncthreads();
                      if (ok) { const float ac = as[grp * 128 + c]; float mx = -INFINITY;
                          for (int s = 0; s <= c; ++s) mx = fmaxf(mx, ac - as[grp * 128 + s] + ls[grp * 128 + s]);
                          const float il = ac + gmp[h * 32 + n]; const float m = fmaxf(il, mx);
                          float* row = Sb + ((size_t)(h * 32 + n) << 14) + c * 128; float d = 0.f;
                          for (int s = 0; s < 128; ++s) { float p = 0.f; if (s <= c) p = expf(ac - as[grp * 128 + s] + ls[grp * 128 + s] - m) * row[s]; row[s] = p; d += p; }
                          mrow[h * SEQ + t] = m; wint[h * SEQ + t] = expf(il - m); den[h * SEQ + t] = d; }
                      __syncthreads();
                  } }
                GRID_BAR();
                bgemm_phase<false, false, false, float, bf16_t>(F, Sb, 128, (long)32 * 16384, 16384, nullptr, 0, 0, hb + 2048, ODD_N, 256, (long)128 * ODD_N, num, 1024, 256, (long)128 * 1024, 128, 32, 128, 256, 128);
                GRID_STRIDE(gid, 4 * SEQ) { const int t = (int)(gid & (SEQ - 1)), h = (int)(gid >> 12), n = t >> 7; const bf16_t* q = hb + (size_t)t * ODD_N + h * 256; const float* np = nprev + (h * 32 + n) * 256;
                    float a = 0.f; for (int i = 0; i < 256; ++i) a = fmaf(bf2f(q[i]), np[i], a); den[gid] += wint[gid] * a; }
                GRID_BAR();
                bgemm_phase<false, false, true, bf16_t, float>(F, hb, ODD_N, 256, (long)128 * ODD_N, wint, SEQ, 128, kvb, 256, (long)32 * 65536, 65536, num, 1024, 256, (long)128 * 1024, 128, 32, 128, 256, 256);
                GRID_BAR();
                GRID_STRIDE(gid, (size_t)SEQ * 1024) { const int c = (int)(gid & 1023), t = (int)(gid >> 10), h = c >> 8;
                    const float dn = fmaxf(fabsf(den[h * SEQ + t]), expf(-mrow[h * SEQ + t]));
                    yb[gid] = (bf16_t)f2bf(num[gid] / dn * sigmoid_f(bf2f(hb[(size_t)t * ODD_N + 3072 + c]))); }
                GRID_BAR();
            }
            mixo = (float*)(ws + L1_MIX);
            { pg8::Gemm g{XB, (const bf16_t*)(ws + W1_OUT), DM, DM, DM}; pg8::StaticOrder S; S.init(M, DM, F.G, (int)blockIdx.x);
              pg8::EpiF32 E{mixo, DM}; pg8::gemm_phase<pg8::EpiF32, false, true>(ring, g, S, E); }
            GRID_BAR();
        }
        ln_phase<true, false>(F, xres, mixo, ln_g + (layer * 2 + 0) * DM, ln_b + (layer * 2 + 0) * DM, out, XB, nullptr, nullptr);
        GRID_BAR();
        { pg8::Gemm g{XB, (const bf16_t*)(ws + (layer == 0 ? W0_UP : W1_UP)), DM, 2 * FF, DM}; pg8::StaticOrder S; S.init(M, 2 * FF, F.G, (int)blockIdx.x);
          pg8::EpiFfn E{(bf16_t*)(ws + F_H), args.in[9] + (size_t)layer * 3 * FF, args.in[10] + (size_t)layer * FF, (float*)(ws + F_GST), (float*)(ws + F_UST)};
          pg8::gemm_phase<pg8::EpiFfn, true>(ring, g, S, E); }
        GRID_BAR();
        ffn_fix_phase((const float*)(ws + F_GST), (const float*)(ws + F_UST), args.in[9] + (size_t)layer * 3 * FF, args.in[10] + (size_t)layer * FF, (bf16_t*)(ws + F_H));
        GRID_BAR();
        { pg8::Gemm g{(const bf16_t*)(ws + F_H), (const bf16_t*)(ws + (layer == 0 ? W0_DOWN : W1_DOWN)), FF, DM, FF}; pg8::StaticOrder S; S.init(M, DM, F.G, (int)blockIdx.x);
          pg8::EpiF32 E{(float*)(ws + F_MIX), DM}; pg8::gemm_phase<pg8::EpiF32, false, true>(ring, g, S, E); }
        GRID_BAR();
        if (layer == 0) ln_phase<true, true>(F, out, (const float*)(ws + F_MIX), ln_g + (layer * 2 + 1) * DM, ln_b + (layer * 2 + 1) * DM, out, XB, args.in[4], (float*)(ws + T_GATES));
        else ln_phase<false, false>(F, out, (const float*)(ws + F_MIX), ln_g + (layer * 2 + 1) * DM, ln_b + (layer * 2 + 1) * DM, out, nullptr, nullptr, nullptr);
        if (layer == 0) GRID_BAR();
    }

__global__ void __launch_bounds__(NTHR, 2) fwd_megakernel(Args args) {
    extern __shared__ __attribute__((aligned(16))) unsigned char lds_raw[];
    cg::grid_group grid = cg::this_grid();
    Frame F;
    F.lds = (LAS unsigned char*)lds_raw;
    F.wave = __builtin_amdgcn_readfirstlane(threadIdx.x >> 6);
    F.G = gridDim.x; { const int bx = blockIdx.x; F.vcu = (F.G % 8 == 0) ? (bx % 8) * (F.G / 8) + bx / 8 : bx; }
    F.ws = args.ws; F.out = args.out;
    unsigned char* ws = args.ws;
    volatile LAS unsigned* MISC = (volatile LAS unsigned*)(F.lds + MISC_OFF);
    for (int u = threadIdx.x; u < (LDS_BYTES - LDSCTL_OFF) / 4; u += NTHR) ((LAS unsigned*)(F.lds + LDSCTL_OFF))[u] = 0u;
    __syncthreads();
    XcdBarrier bar = xcd_barrier_post((unsigned*)(ws + WS_CTL) + 4096, MISC + 8);

    p0_prologue(F, args);
    grid.sync();

    run_layer<0>(F, args, bar);
    run_layer<1>(F, args, bar);
}
static_assert(T_SMALL + 8192 <= WS_W1, "small arrays");
static_assert(6 * 4 * SEQ + 3 * 128 + 32768 + 32768 <= 196608 && L1_SCR + 56 * MiB + (size_t)NB * 196608 * 4 <= WS_END, "naive mLSTM smalls");

extern "C" void kernel_launch(void* const* d_in, const int* in_sizes, int n_in, void* d_out, int out_size, void* d_ws, size_t ws_size, hipStream_t stream) {
    static int grid = 0;
    if (grid == 0) {
        if (n_in != 14 || ws_size < WS_END) { fprintf(stderr, "kernel_launch: unexpected n_in %d / ws %zu\n", n_in, ws_size); grid = -1; return; }
        int dev = 0, cus = 0, per_cu = 0;
        hipGetDevice(&dev);
        hipDeviceGetAttribute(&cus, hipDeviceAttributeMultiprocessorCount, dev);
        if (hipFuncSetAttribute((const void*)fwd_megakernel, hipFuncAttributeMaxDynamicSharedMemorySize, LDS_BYTES) != hipSuccess) { fprintf(stderr, "kernel_launch: hipFuncSetAttribute failed\n"); grid = -1; return; }
        if (hipOccupancyMaxActiveBlocksPerMultiprocessor(&per_cu, (const void*)fwd_megakernel, NTHR, LDS_BYTES) != hipSuccess || per_cu < 1) { fprintf(stderr, "kernel_launch: occupancy query says %d\n", per_cu); per_cu = 1; }
        (void)hipGetLastError();
        grid = cus * 1;
        fprintf(stderr, "kernel_launch: grid %d (cus %d, per_cu %d)\n", grid, cus, per_cu);
    }
    if (grid < 0) return;
    hipMemsetAsync((char*)d_ws + WS_CTL, 0, CTL_ZERO_BYTES, stream);
    Args a{};
    for (int i = 0; i < 14; ++i) a.in[i] = (const float*)d_in[i];
    a.out = (float*)d_out; a.ws = (unsigned char*)d_ws;
    void* kargs[] = {&a};
    hipError_t e = hipLaunchCooperativeKernel((const void*)fwd_megakernel, dim3(grid), dim3(NTHR), kargs, LDS_BYTES, stream);
    if (e != hipSuccess) fprintf(stderr, "cooperative launch failed: %s (grid %d)\n", hipGetErrorString(e), grid);
}
```

```cpp
#include <hip/hip_runtime.h>
#include <hip/hip_cooperative_groups.h>
#include <cmath>
#include <cstdio>
#include <cstdint>
namespace cg = cooperative_groups;

#define LAS __attribute__((address_space(3)))
#define GAS __attribute__((address_space(1)))
typedef unsigned short bf16_t;
typedef short bf16x8 __attribute__((ext_vector_type(8)));
typedef float f32x4 __attribute__((ext_vector_type(4)));
typedef float f32x2 __attribute__((ext_vector_type(2)));
typedef unsigned u32x4 __attribute__((ext_vector_type(4)));
typedef unsigned u32x2 __attribute__((ext_vector_type(2)));

constexpr int DM = 1024, NB = 4, SEQ = 4096, M = NB * SEQ, FF = 2816;
constexpr int EVEN_IN = 3584, ODD_IN = 4104, ODD_N = 4096;
constexpr float LN_EPS = 1e-5f;
constexpr float ALPHA = 1.41421356237309515f;
constexpr int NWAVES = 8, NTHR = 512;

constexpr size_t MiB = 1u << 20;
constexpr size_t WS_CTL = 0, CTL_ZERO_BYTES = 1 * MiB;
constexpr size_t WS_TAB = 1 * MiB;
constexpr size_t WS_W1 = 5 * MiB;
constexpr size_t WS_XB = 5 * MiB + 27 * MiB - MiB / 2;
constexpr size_t WS_W0 = WS_XB + 32 * MiB;
constexpr size_t WS_R = WS_W0 + 26 * MiB - MiB / 2;
constexpr size_t WS_END = 256 * MiB;
constexpr size_t T_COS = WS_TAB, T_SIN = T_COS + MiB, T_BTAB = T_SIN + MiB;
constexpr size_t T_GATES = T_BTAB + 16384;
constexpr size_t T_SMALL = T_GATES + 512 * 1024;
constexpr size_t W1_IN = WS_W1, W1_OUT = W1_IN + 8 * MiB, W1_UP = W1_OUT + 2 * MiB, W1_DOWN = W1_UP + 11 * MiB;
constexpr size_t W0_IN = WS_W0, W0_OUT = W0_IN + 7 * MiB, W0_UP = W0_OUT + 2 * MiB, W0_DOWN = W0_UP + 11 * MiB;
static_assert(W1_DOWN + 5 * MiB + MiB / 2 <= WS_XB && W0_DOWN + 5 * MiB + MiB / 2 <= WS_R, "weights map");
constexpr size_t L0_H = WS_R, L0_SCR = WS_R + 112 * MiB;
constexpr size_t L1_H = WS_W0, L1_SCR = WS_W0 + 128 * MiB;
static_assert(L1_SCR + 64 * MiB <= WS_END && L0_SCR + 32 * MiB <= WS_END, "scratch map");
constexpr size_t F_H = WS_R, F_MIX = WS_R + 88 * MiB, F_GST = 233 * MiB, F_UST = F_GST + 11 * MiB;
static_assert(F_MIX + 64 * MiB <= WS_END && F_UST + 6 * MiB <= WS_END, "ffn map");
constexpr size_t L0_MIX = WS_R, L1_MIX = L1_SCR;
constexpr size_t L1_ST4 = L1_SCR;

constexpr int LDS_BYTES = 163840, LDSCTL_OFF = LDS_BYTES - 512, MISC_OFF = LDSCTL_OFF + 320, SCR_BYTES = LDSCTL_OFF;

__device__ __forceinline__ unsigned f2bf(float f) { unsigned u = __builtin_bit_cast(unsigned, f); return (u + 0x7fffu + ((u >> 16) & 1u)) >> 16; }
__device__ __forceinline__ unsigned pk2(float lo, float hi) { return f2bf(lo) | (f2bf(hi) << 16); }
__device__ __forceinline__ float bf2f(unsigned short b) { return __builtin_bit_cast(float, (unsigned)b << 16); }
__device__ __forceinline__ float bflo(unsigned w) { return __builtin_bit_cast(float, w << 16); }
__device__ __forceinline__ float bfhi(unsigned w) { return __builtin_bit_cast(float, w & 0xffff0000u); }
__device__ __forceinline__ unsigned cvt_pk_bf16(float lo, float hi) { unsigned r; asm volatile("v_cvt_pk_bf16_f32 %0, %1, %2" : "=v"(r) : "v"(lo), "v"(hi)); return r; }
__device__ __forceinline__ float wave_sum(float v) {
#pragma unroll
    for (int o = 1; o < 64; o <<= 1) v += __shfl_xor(v, o);
    return v;
}
__device__ __forceinline__ float silu_f(float x) { return x / (1.f + __expf(-x)); }
__device__ __forceinline__ float silu_acc(float x) { return x / (1.f + expf(-x)); }
__device__ __forceinline__ float sigmoid_f(float x) { return 1.f / (1.f + expf(-x)); }
__device__ __forceinline__ float log_sigmoid_f(float x) { return fminf(x, 0.f) - log1pf(expf(-fabsf(x))); }
__device__ __forceinline__ float ret_lg(int h) { return log1pf(-exp2f(-5.f - (float)h)); }
template <int CTRL> __device__ __forceinline__ float dpp_mov(float old, float src) {
    return __builtin_bit_cast(float, __builtin_amdgcn_update_dpp(__builtin_bit_cast(int, old), __builtin_bit_cast(int, src), CTRL, 0xF, 0xF, false));
}

namespace pg8 {
constexpr int BM = 256, BK = 64, HALF = 128, HTB = HALF * BK * 2, STAGE_BYTES = 8 * HTB, NXCD = 8, WGM = 8;
__host__ __device__ __forceinline__ int lds_byte(int r, int c) { const int st = (r >> 4) * 2 + (c >> 5), rr = r & 15, cc = c & 31, ob = rr * 64 + cc * 2; return st * 1024 + (ob ^ (((ob >> 9) & 1) << 5)); }
__host__ __device__ __forceinline__ void stage_rc(int b, int& R, int& C) { const int st = b / 1024, sb = b % 1024, swz = sb ^ (((sb >> 9) & 1) << 5); R = (st >> 1) * 16 + swz / 64; C = (st & 1) * 32 + (swz % 64) / 2; }
__host__ __device__ __forceinline__ int perm32(int rho) { const int n = rho >> 4, i = rho & 15; return 8 * (i >> 2) + 4 * n + (i & 3); }
struct Unit { int pm, pn; };
struct Gemm { const bf16_t* A; const bf16_t* Bt; int lda, N, K; };
struct StaticOrder {
    int nM, nN, nwg, G, c;
    __device__ void init(int Mr, int N, int G_, int c_) { nM = Mr / BM; nN = N / BM; nwg = nM * nN; G = G_; c = c_; }
    __device__ bool next(int i, Unit& u) const {
        const long L = (long)i * G + c; if (L >= nwg) return false;
        int wgid = (int)L; { const int q = nwg / NXCD, r = nwg % NXCD, xcd = wgid % NXCD, off = wgid / NXCD; wgid = (xcd < r ? xcd * (q + 1) : r * (q + 1) + (xcd - r) * q) + off; }
        const int nig = WGM * nN, gid = wgid / nig, fm = gid * WGM, gsz = (nM - fm) < WGM ? (nM - fm) : WGM;
        u.pm = fm + ((wgid % nig) % gsz); u.pn = (wgid % nig) / gsz; return true;
    }
};

template <class Epi, bool ALIGN_EPI, bool SINGLE = false>
__device__ __forceinline__ void gemm_phase(LAS unsigned char* lds, const Gemm g, const StaticOrder& S, const Epi& E) {
    int tid_ = threadIdx.x; asm volatile("" : "+v"(tid_));
    const int tid = tid_, wid = __builtin_amdgcn_readfirstlane(tid >> 6), lane = tid & 63, wr = wid >> 2, wc = wid & 3, fr = lane & 15, fq = lane >> 4;
    const int K = g.K, nt = K / BK, lda = g.lda;
    unsigned voffA[2], voffB[2];
#pragma unroll
    for (int i = 0; i < 2; ++i) { int R, C; stage_rc(tid * 16 + i * 8192, R, C); const int Rb = Epi::PERM ? ((R & ~31) + perm32(R & 31)) : R;
        voffA[i] = (unsigned)(R * lda + C) * 2u; voffB[i] = (unsigned)(Rb * K + C) * 2u; }
    const size_t kstep = (size_t)(BK * 2);
    const size_t hstepA = (size_t)HALF * lda * 2, tstepA = 2 * hstepA;
    const size_t hstepB = (size_t)HALF * K * 2, tstepB = 2 * hstepB;
    const unsigned ldsw = (unsigned)wid * 1024u;
    const int aoff = lds_byte(wr * 64 + fr, fq * 8), boff = lds_byte(wc * 32 + fr, fq * 8);
#define PG8_SA(b, h) (((b) * 2 + (h)) * HTB)
#define PG8_SB(b, h) ((4 + (b) * 2 + (h)) * HTB)
#define PG8_STAGE(bufoff, gbase, voff) do { _Pragma("unroll") for (int _i = 0; _i < 2; ++_i) \
        __builtin_amdgcn_global_load_lds((const unsigned*)((const char*)(gbase) + (voff)[_i]), (LAS unsigned*)(lds + (bufoff) + ldsw + _i * 8192), 16, 0, 0); } while (0)
#define PG8_LDA(dst, b, h) do { _Pragma("unroll") for (int m = 0; m < 4; ++m) _Pragma("unroll") for (int k = 0; k < 2; ++k) dst[m][k] = *(const LAS bf16x8*)(lds + PG8_SA(b, h) + aoff + m * 2048 + k * 1024); } while (0)
#define PG8_LDB(dst, b, h) do { _Pragma("unroll") for (int n = 0; n < 2; ++n) _Pragma("unroll") for (int k = 0; k < 2; ++k) dst[n][k] = *(const LAS bf16x8*)(lds + PG8_SB(b, h) + boff + n * 2048 + k * 1024); } while (0)
#define PG8_MMA(ai, bj, At, Bt) do { __builtin_amdgcn_s_setprio(1); _Pragma("unroll") for (int m = 0; m < 4; ++m) _Pragma("unroll") for (int n = 0; n < 2; ++n) _Pragma("unroll") for (int k = 0; k < 2; ++k) \
        acc[ai][bj][m][n] = __builtin_amdgcn_mfma_f32_16x16x32_bf16(Bt[n][k], At[m][k], acc[ai][bj][m][n], 0, 0, 0); __builtin_amdgcn_s_setprio(0); } while (0)
#define PG8_WAIT_V(n) asm volatile("s_waitcnt vmcnt(" #n ")" ::: "memory")
#define PG8_WAIT_L(n) asm volatile("s_waitcnt lgkmcnt(" #n ")" ::: "memory")
#define PG8_BAR __builtin_amdgcn_s_barrier()
#define PG8_SCHED __builtin_amdgcn_sched_barrier(0)
    Unit cur, nxt; int ui = 0;
    if (!S.next(0, cur)) return;
    f32x4 acc[2][2][4][2];
#pragma unroll
    for (int a = 0; a < 2; ++a)
#pragma unroll
        for (int b = 0; b < 2; ++b)
#pragma unroll
            for (int m = 0; m < 4; ++m)
#pragma unroll
                for (int n = 0; n < 2; ++n) acc[a][b][m][n] = (f32x4){0.f, 0.f, 0.f, 0.f};
    bf16x8 At[4][2], B0[2][2], B1[2][2];
    const char* cA = (const char*)g.A + (size_t)cur.pm * tstepA; const char* cB = (const char*)g.Bt + (size_t)cur.pn * tstepB;
    {
        PG8_STAGE(PG8_SB(0, 0), cB, voffB); PG8_STAGE(PG8_SB(0, 1), cB + hstepB, voffB); PG8_STAGE(PG8_SA(0, 0), cA, voffA); PG8_STAGE(PG8_SA(0, 1), cA + hstepA, voffA);
        if (wr == 1) PG8_BAR;
        PG8_WAIT_V(2); PG8_BAR;
        PG8_STAGE(PG8_SB(1, 0), cB + kstep, voffB); PG8_STAGE(PG8_SA(1, 0), cA + kstep, voffA); PG8_STAGE(PG8_SB(1, 1), cB + hstepB + kstep, voffB);
        PG8_WAIT_V(6); PG8_BAR;
    }
    for (;;) {
        const bool has_next = SINGLE ? false : S.next(ui + 1, nxt);
        const char* nA = has_next ? (const char*)g.A + (size_t)nxt.pm * tstepA : cA; const char* nB = has_next ? (const char*)g.Bt + (size_t)nxt.pn * tstepB : cB;
        for (int t = 0; t < nt; t += 2) {
            const bool last = (t == nt - 2);
            const char* a1 = cA + (size_t)(t + 1) * kstep;
            const char* a2 = last ? nA : cA + (size_t)(t + 2) * kstep; const char* b2 = last ? nB : cB + (size_t)(t + 2) * kstep;
            const char* a3 = a2 + kstep; const char* b3 = b2 + kstep;
            PG8_LDB(B0, 0, 0); PG8_LDB(B1, 0, 1); PG8_SCHED; PG8_LDA(At, 0, 0); PG8_STAGE(PG8_SA(1, 1), a1 + hstepA, voffA);
            PG8_WAIT_V(8); PG8_WAIT_L(0); PG8_BAR; PG8_MMA(0, 0, At, B0); PG8_MMA(0, 1, At, B1); PG8_BAR; PG8_SCHED;
            PG8_LDA(At, 0, 1); PG8_STAGE(PG8_SB(0, 0), b2, voffB); PG8_STAGE(PG8_SB(0, 1), b2 + hstepB, voffB); PG8_STAGE(PG8_SA(0, 0), a2, voffA);
            PG8_WAIT_V(8); PG8_WAIT_L(0); PG8_BAR; PG8_MMA(1, 0, At, B0); PG8_MMA(1, 1, At, B1); PG8_BAR; PG8_SCHED;
            PG8_LDB(B0, 1, 0); PG8_LDB(B1, 1, 1); PG8_SCHED; PG8_LDA(At, 1, 0); PG8_STAGE(PG8_SA(0, 1), a2 + hstepA, voffA);
            PG8_WAIT_V(8); PG8_WAIT_L(0); PG8_BAR; PG8_MMA(0, 0, At, B0); PG8_MMA(0, 1, At, B1); PG8_BAR; PG8_SCHED;
            PG8_LDA(At, 1, 1); PG8_STAGE(PG8_SB(1, 0), b3, voffB); PG8_STAGE(PG8_SB(1, 1), b3 + hstepB, voffB); PG8_STAGE(PG8_SA(1, 0), a3, voffA);
            PG8_WAIT_V(8); PG8_WAIT_L(0); PG8_BAR; PG8_MMA(1, 0, At, B0); PG8_MMA(1, 1, At, B1); PG8_BAR; PG8_SCHED;
        }
        if constexpr (ALIGN_EPI) { if (wr == 0) PG8_BAR; }
        { int fr_ = fr, fq_ = fq; asm volatile("" : "+v"(fr_), "+v"(fq_));
          E(acc, cur, wr, wc, fr_, fq_); }
        if (!has_next) break;
#pragma unroll
        for (int a = 0; a < 2; ++a)
#pragma unroll
            for (int b = 0; b < 2; ++b)
#pragma unroll
                for (int m = 0; m < 4; ++m)
#pragma unroll
                    for (int n = 0; n < 2; ++n) acc[a][b][m][n] = (f32x4){0.f, 0.f, 0.f, 0.f};
        cur = nxt; cA = nA; cB = nB; ++ui;
        if constexpr (ALIGN_EPI) { if (wr == 1) PG8_BAR; }
    }
    PG8_WAIT_V(0);
    if constexpr (!ALIGN_EPI) { if (wr == 0) PG8_BAR; }
    PG8_BAR;
#undef PG8_SA
#undef PG8_SB
#undef PG8_STAGE
#undef PG8_LDA
#undef PG8_LDB
#undef PG8_MMA
#undef PG8_WAIT_V
#undef PG8_WAIT_L
#undef PG8_BAR
#undef PG8_SCHED
}

struct EpiF32 {
    static constexpr bool PERM = false;
    float* C; int ldc;
    __device__ __forceinline__ void operator()(const f32x4 (&acc)[2][2][4][2], const Unit& u, int wr, int wc, int fr, int fq) const {
        const int row0 = u.pm * BM + wr * 64 + fr, col0 = u.pn * BM + wc * 32 + 4 * fq;
#pragma unroll
        for (int ai = 0; ai < 2; ++ai)
#pragma unroll
            for (int m = 0; m < 4; ++m) { float* rowp = C + (size_t)(row0 + ai * HALF + m * 16) * ldc + col0;
#pragma unroll
                for (int bj = 0; bj < 2; ++bj)
#pragma unroll
                    for (int n = 0; n < 2; ++n) *(f32x4*)(rowp + bj * HALF + n * 16) = acc[ai][bj][m][n]; }
    }
};
struct EpiH0 {
    static constexpr bool PERM = true;
    bf16_t* O; const float* cs; const float* sn;
    __device__ __forceinline__ void operator()(const f32x4 (&acc)[2][2][4][2], const Unit& u, int wr, int wc, int fr, int fq) const {
        const int row0 = u.pm * BM + wr * 64 + fr;
        if (u.pn < 4) {
            const int cc = wc * 32 + 8 * fq;
            const int head = 2 * (u.pn & 1) + (cc >> 6), i0 = cc & 63;
            const float sc = (u.pn >= 2) ? 0.08838834764831845f : 1.f;
            bf16_t* base = O + (u.pn >= 2 ? 512 : 0) + head * 128 + i0;
#pragma unroll
            for (int ai = 0; ai < 2; ++ai)
#pragma unroll
                for (int m = 0; m < 4; ++m) {
                    const int row = row0 + ai * HALF + m * 16, pos = row & (SEQ - 1);
                    const f32x4 c0 = *(const f32x4*)(cs + pos * 64 + i0), c1 = *(const f32x4*)(cs + pos * 64 + i0 + 4);
                    const f32x4 s0 = *(const f32x4*)(sn + pos * 64 + i0), s1 = *(const f32x4*)(sn + pos * 64 + i0 + 4);
                    const f32x4 a0 = acc[ai][0][m][0], a1 = acc[ai][0][m][1], b0 = acc[ai][1][m][0], b1 = acc[ai][1][m][1];
                    const f32x4 o10 = (a0 * c0 - b0 * s0) * sc, o11 = (a1 * c1 - b1 * s1) * sc, o20 = (a0 * s0 + b0 * c0) * sc, o21 = (a1 * s1 + b1 * c1) * sc;
                    u32x4 w1, w2;
                    w1.x = cvt_pk_bf16(o10[0], o10[1]); w1.y = cvt_pk_bf16(o10[2], o10[3]); w1.z = cvt_pk_bf16(o11[0], o11[1]); w1.w = cvt_pk_bf16(o11[2], o11[3]);
                    w2.x = cvt_pk_bf16(o20[0], o20[1]); w2.y = cvt_pk_bf16(o20[2], o20[3]); w2.z = cvt_pk_bf16(o21[0], o21[1]); w2.w = cvt_pk_bf16(o21[2], o21[3]);
                    bf16_t* rp = base + (size_t)row * EVEN_IN;
                    *(u32x4*)rp = w1; *(u32x4*)(rp + 64) = w2;
                }
        } else {
            const int col0 = u.pn * BM + wc * 32 + 8 * fq;
#pragma unroll
            for (int ai = 0; ai < 2; ++ai)
#pragma unroll
                for (int m = 0; m < 4; ++m) { bf16_t* rowp = O + (size_t)(row0 + ai * HALF + m * 16) * EVEN_IN + col0;
#pragma unroll
                    for (int bj = 0; bj < 2; ++bj) { const f32x4 v0 = acc[ai][bj][m][0], v1 = acc[ai][bj][m][1]; u32x4 w;
                        w.x = cvt_pk_bf16(v0[0], v0[1]); w.y = cvt_pk_bf16(v0[2], v0[3]); w.z = cvt_pk_bf16(v1[0], v1[1]); w.w = cvt_pk_bf16(v1[2], v1[3]);
                        *(u32x4*)(rowp + bj * HALF) = w; } }
        }
    }
};
struct EpiFfn {
    static constexpr bool PERM = true;
    bf16_t* H; const float* cw; const float* cb; float* gst; float* ust;
    __device__ __forceinline__ void operator()(const f32x4 (&acc)[2][2][4][2], const Unit& u, int wr, int wc, int fr, int fq) const {
        const int ch0 = u.pn * 128 + wc * 32 + 8 * fq;
#pragma unroll
        for (int ai = 0; ai < 2; ++ai) {
            const int blk = u.pm * 4 + ai * 2 + wr, rowb = blk * 64;
            unsigned ow[4][4];
#pragma unroll
            for (int n = 0; n < 2; ++n) {
                const f32x4 w0 = *(const f32x4*)(cw + ch0 + 4 * n), w1 = *(const f32x4*)(cw + FF + ch0 + 4 * n), w2 = *(const f32x4*)(cw + 2 * FF + ch0 + 4 * n), bb = *(const f32x4*)(cb + ch0 + 4 * n);
                float hv[4][4];
#pragma unroll
                for (int j = 0; j < 4; ++j) {
#pragma unroll
                    for (int m = 0; m < 4; ++m) {
                        const float g = acc[ai][0][m][n][j];
                        float p1, p2;
                        if (m == 0) { p1 = dpp_mov<0x111>(0.f, g); p2 = dpp_mov<0x112>(0.f, g); }
                        else { const float gp = acc[ai][0][m - 1][n][j]; p1 = dpp_mov<0x111>(dpp_mov<0x121>(0.f, gp), g); p2 = dpp_mov<0x112>(dpp_mov<0x122>(0.f, gp), g); }
                        const float cv = fmaf(w0[j], p2, fmaf(w1[j], p1, fmaf(w2[j], g, bb[j])));
                        hv[m][j] = silu_f(cv) * acc[ai][1][m][n][j];
                    }
                }
#pragma unroll
                for (int m = 0; m < 4; ++m) { ow[m][2 * n] = cvt_pk_bf16(hv[m][0], hv[m][1]); ow[m][2 * n + 1] = cvt_pk_bf16(hv[m][2], hv[m][3]); }
                if (fr >= 14) *(f32x4*)(gst + ((size_t)blk * 4 + (fr - 14)) * FF + ch0 + 4 * n) = acc[ai][0][3][n];
                if (fr < 2) { *(f32x4*)(gst + ((size_t)blk * 4 + 2 + fr) * FF + ch0 + 4 * n) = acc[ai][0][0][n]; *(f32x4*)(ust + ((size_t)blk * 2 + fr) * FF + ch0 + 4 * n) = acc[ai][1][0][n]; }
            }
#pragma unroll
            for (int m = 0; m < 4; ++m) if (m > 0 || fr >= 2) { u32x4 w; w.x = ow[m][0]; w.y = ow[m][1]; w.z = ow[m][2]; w.w = ow[m][3]; *(u32x4*)(H + (size_t)(rowb + m * 16 + fr) * FF + ch0) = w; }
        }
    }
};
struct EpiH1 {
    static constexpr bool PERM = true;
    bf16_t* O; const float* cw; float* st4;
    __device__ __forceinline__ void operator()(const f32x4 (&acc)[2][2][4][2], const Unit& u, int wr, int wc, int fr, int fq) const {
        if (u.pn < 8) {
            const float osc = (u.pn >= 4) ? 0.0625f : 1.f;
#pragma unroll
            for (int ai = 0; ai < 2; ++ai) {
                const int blk = u.pm * 4 + ai * 2 + wr, rowb = blk * 64;
#pragma unroll
                for (int bj = 0; bj < 2; ++bj) {
                    const int ch0 = u.pn * 256 + bj * 128 + wc * 32 + 8 * fq;
                    unsigned ow[4][4];
#pragma unroll
                    for (int n = 0; n < 2; ++n) {
                        const f32x4 w0 = *(const f32x4*)(cw + ch0 + 4 * n), w1 = *(const f32x4*)(cw + 2048 + ch0 + 4 * n), w2 = *(const f32x4*)(cw + 4096 + ch0 + 4 * n), w3 = *(const f32x4*)(cw + 6144 + ch0 + 4 * n);
                        float hv[4][4];
#pragma unroll
                        for (int j = 0; j < 4; ++j) {
#pragma unroll
                            for (int m = 0; m < 4; ++m) {
                                const float g = acc[ai][bj][m][n][j];
                                float p1, p2, p3;
                                if (m == 0) { p1 = dpp_mov<0x111>(0.f, g); p2 = dpp_mov<0x112>(0.f, g); p3 = dpp_mov<0x113>(0.f, g); }
                                else { const float gp = acc[ai][bj][m - 1][n][j]; p1 = dpp_mov<0x111>(dpp_mov<0x121>(0.f, gp), g); p2 = dpp_mov<0x112>(dpp_mov<0x122>(0.f, gp), g); p3 = dpp_mov<0x113>(dpp_mov<0x123>(0.f, gp), g); }
                                const float cv = fmaf(w0[j], p3, fmaf(w1[j], p2, fmaf(w2[j], p1, w3[j] * g)));
                                hv[m][j] = silu_f(cv) * osc;
                            }
                        }
#pragma unroll
                        for (int m = 0; m < 4; ++m) { ow[m][2 * n] = cvt_pk_bf16(hv[m][0], hv[m][1]); ow[m][2 * n + 1] = cvt_pk_bf16(hv[m][2], hv[m][3]); }
                        if (fr >= 13) *(f32x4*)(st4 + ((size_t)blk * 6 + (fr - 13)) * 2048 + ch0 + 4 * n) = acc[ai][bj][3][n];
                        if (fr < 3) *(f32x4*)(st4 + ((size_t)blk * 6 + 3 + fr) * 2048 + ch0 + 4 * n) = acc[ai][bj][0][n];
                    }
#pragma unroll
                    for (int m = 0; m < 4; ++m) if (m > 0 || fr >= 3) { u32x4 w; w.x = ow[m][0]; w.y = ow[m][1]; w.z = ow[m][2]; w.w = ow[m][3]; *(u32x4*)(O + (size_t)(rowb + m * 16 + fr) * ODD_N + ch0) = w; }
                }
            }
        } else {
            const int row0 = u.pm * BM + wr * 64 + fr, col0 = u.pn * BM + wc * 32 + 8 * fq;
#pragma unroll
            for (int ai = 0; ai < 2; ++ai)
#pragma unroll
                for (int m = 0; m < 4; ++m) { bf16_t* rowp = O + (size_t)(row0 + ai * HALF + m * 16) * ODD_N + col0;
#pragma unroll
                    for (int bj = 0; bj < 2; ++bj) { const f32x4 v0 = acc[ai][bj][m][0], v1 = acc[ai][bj][m][1]; u32x4 w;
                        w.x = cvt_pk_bf16(v0[0], v0[1]); w.y = cvt_pk_bf16(v0[2], v0[3]); w.z = cvt_pk_bf16(v1[0], v1[1]); w.w = cvt_pk_bf16(v1[2], v1[3]);
                        *(u32x4*)(rowp + bj * HALF) = w; } }
        }
    }
};
}

#define XB_TMO      128
#define XB_XCNT(j)  (256  + 64 * (j))
#define XB_XSUB(j)  (1280 + 64 * (j))
#define XB_XGEN(j)  (2304 + 64 * (j))
#define XB_TOP      3328
#define XB_TOPGEN   3392
#define XCD_BAR_WORDS 3456
#define XB_SPIN_CAP (1u << 20)
__device__ __forceinline__ unsigned xb_ld(unsigned* p)              { return __hip_atomic_load(p, __ATOMIC_RELAXED, __HIP_MEMORY_SCOPE_AGENT); }
__device__ __forceinline__ unsigned xb_add(unsigned* p, unsigned v) { return __hip_atomic_fetch_add(p, v, __ATOMIC_RELAXED, __HIP_MEMORY_SCOPE_AGENT); }
__device__ __forceinline__ unsigned xb_xcc_id() { return (unsigned)__builtin_amdgcn_s_getreg((3 << 11) | 20) & 0xFu; }
#define XB_SPIN(cond, bar) do { unsigned _sp = 0; while (cond) { __builtin_amdgcn_s_sleep(1); \
    if ((++_sp & 255u) == 0u) { if (xb_ld(&(bar)[XB_TMO])) break; if (_sp > XB_SPIN_CAP) { atomicAdd(&(bar)[XB_TMO], 1u); break; } } } } while (0)
struct XcdBarrier { unsigned* bar; unsigned x; volatile LAS unsigned* st; };
__device__ __forceinline__ XcdBarrier xcd_barrier_post(unsigned* bar, volatile LAS unsigned* st) {
    XcdBarrier b; b.bar = bar; b.x = xb_xcc_id(); b.st = st;
    if (threadIdx.x == 0) (void)xb_add(&bar[XB_XCNT(b.x)], 1u);
    return b;
}
__device__ __forceinline__ void xcd_barrier_complete(unsigned* bar, unsigned x, unsigned& nloc, unsigned& nx) {
    const unsigned G = gridDim.x * gridDim.y * gridDim.z;
    unsigned sum, cnt, mine, sp = 0u;
    for (;;) {
        sum = 0u; cnt = 0u; mine = 0u;
#pragma unroll
        for (unsigned j = 0; j < 16; ++j) { const unsigned c = xb_ld(&bar[XB_XCNT(j)]); sum += c; cnt += (c > 0u) ? 1u : 0u; mine = (j == x) ? c : mine; }
        if (sum == G) break;
        __builtin_amdgcn_s_sleep(1);
        if ((++sp & 255u) == 0u) { if (xb_ld(&bar[XB_TMO])) break; if (sp > XB_SPIN_CAP) { atomicAdd(&bar[XB_TMO], 1u); break; } }
    }
    nloc = mine > 0u ? mine : 1u; nx = cnt > 0u ? cnt : 1u;
}
__device__ __forceinline__ void xcd_barrier(const XcdBarrier& b) {
    asm volatile("s_waitcnt vmcnt(0)" ::: "memory");
    __syncthreads();
    if (threadIdx.x == 0) {
        unsigned* bar = b.bar;
        __builtin_amdgcn_s_waitcnt(0);
        unsigned nloc = b.st[0], nx = b.st[1];
        if (nloc == 0u) { xcd_barrier_complete(bar, b.x, nloc, nx); b.st[0] = nloc; b.st[1] = nx; }
        const unsigned old = xb_add(&bar[XB_XSUB(b.x)], 1u);
        const unsigned gen = old / nloc;
        if (old + 1u == (gen + 1u) * nloc) {
            __builtin_amdgcn_fence(__ATOMIC_RELEASE, "agent");
            asm volatile("s_waitcnt vmcnt(0)" ::: "memory");
            const unsigned og = xb_add(&bar[XB_TOP], 1u);
            const unsigned tg = og / nx;
            if (og + 1u == (tg + 1u) * nx) xb_add(&bar[XB_TOPGEN], 1u);
            else XB_SPIN(xb_ld(&bar[XB_TOPGEN]) == tg, bar);
            __builtin_amdgcn_fence(__ATOMIC_ACQUIRE, "agent");
            xb_add(&bar[XB_XGEN(b.x)], 1u);
            asm volatile("s_waitcnt vmcnt(0)" ::: "memory");
        } else {
            XB_SPIN(xb_ld(&bar[XB_XGEN(b.x)]) == gen, bar);
            __builtin_amdgcn_fence(__ATOMIC_ACQUIRE, "agent");
            asm volatile("s_waitcnt vmcnt(0)" ::: "memory");
        }
    }
    __syncthreads();
}

__device__ __forceinline__ int fresh_tid() { int t = threadIdx.x; asm volatile("" : "+v"(t)); return t; }
struct Args { const float* in[14]; float* out; unsigned char* ws; };
struct Frame {
    LAS unsigned char* lds; int wave, vcu, G; unsigned char* ws; float* out;
    __device__ __forceinline__ int ftid() const { return fresh_tid(); }
};
#define GRID_STRIDE(i, n) for (size_t i = (size_t)blockIdx.x * NTHR + fresh_tid(); i < (size_t)(n); i += (size_t)gridDim.x * NTHR)

__device__ __forceinline__ void p0_transpose_item(const float* W, int K, int ldw, bf16_t* WT, int k0, int n0, int dst_row0, LAS float* scr, int lane) {
#pragma unroll 8
    for (int i = 0; i < 32; ++i) { const int kk = 2 * i + (lane >> 5); scr[kk * 33 + (lane & 31)] = W[(size_t)(k0 + kk) * ldw + n0 + (lane & 31)]; }
    asm volatile("s_waitcnt lgkmcnt(0)" ::: "memory");
    const int c = lane & 7;
#pragma unroll
    for (int j = 0; j < 4; ++j) { const int n = (lane >> 3) + 8 * j; const LAS float* s = scr + (8 * c) * 33 + n;
        u32x4 o; o.x = pk2(s[0 * 33], s[1 * 33]); o.y = pk2(s[2 * 33], s[3 * 33]); o.z = pk2(s[4 * 33], s[5 * 33]); o.w = pk2(s[6 * 33], s[7 * 33]);
        *(u32x4*)(WT + (size_t)(dst_row0 + n) * K + k0 + 8 * c) = o; }
    asm volatile("s_waitcnt lgkmcnt(0)" ::: "memory");
}
__device__ __forceinline__ int map_even_in(int c) {
    if (c >= 1024) return c;
    const int blk = c >> 9, cc = c & 511, head = cc >> 7, i128 = cc & 127, half = i128 >> 6, i = i128 & 63;
    return 256 * (blk * 2 + (head >> 1)) + 128 * half + 64 * (head & 1) + i;
}
__device__ __forceinline__ int map_up(int c) { if (c < FF) return 256 * (c >> 7) + (c & 127); const int ch = c - FF; return 256 * (ch >> 7) + 128 + (ch & 127); }
__device__ __forceinline__ int map_id(int c) { return c; }

template <int MAP>
__device__ __forceinline__ void p0_weight(const Frame& F, const float* W, int K, int ldw, int Ncols, bf16_t* WT) {
    LAS float* scr = (LAS float*)(F.lds + F.wave * 16384);
    const int gw = F.vcu * NWAVES + F.wave, NGW = F.G * NWAVES;
    const int nblk = Ncols / 32, nitems = (K / 64) * nblk; const int lane = F.ftid() & 63;
    for (int it = gw; it < nitems; it += NGW) {
        const int kb = it / nblk, nb = it % nblk, n0 = nb * 32;
        const int d0 = MAP == 1 ? map_even_in(n0) : (MAP == 2 ? map_up(n0) : n0);
        p0_transpose_item(W, K, ldw, WT, kb * 64, n0, d0, scr, lane);
    }
}
__device__ __forceinline__ int t5_bucket(int n) {
    if (n < 16) return n;
    int b = 16;
    b += (n >= 22); b += (n >= 30); b += (n >= 40); b += (n >= 54); b += (n >= 73); b += (n >= 99); b += (n >= 134); b += (n >= 182);
    b += (n >= 246); b += (n >= 332); b += (n >= 450); b += (n >= 609); b += (n >= 825); b += (n >= 1117); b += (n >= 1513);
    return b;
}
__device__ const double INV_TAB[64] = {1.0, 0.8659643233600653, 0.7498942093324559, 0.6493816315762113, 0.5623413251903491, 0.4869675251658631, 0.4216965034285822, 0.3651741272548377, 0.31622776601683794, 0.27384196342643613, 0.23713737056616552, 0.2053525026457146, 0.1778279410038923, 0.1539926526059492, 0.1333521432163324, 0.11547819846894582, 0.1, 0.08659643233600653, 0.07498942093324558, 0.06493816315762113, 0.05623413251903491, 0.04869675251658631, 0.042169650342858224, 0.03651741272548377, 0.03162277660168379, 0.027384196342643614, 0.023713737056616554, 0.02053525026457146, 0.01778279410038923, 0.01539926526059492, 0.01333521432163324, 0.011547819846894581, 0.01, 0.008659643233600654, 0.007498942093324558, 0.006493816315762113, 0.005623413251903491, 0.004869675251658631, 0.004216965034285823, 0.003651741272548377, 0.0031622776601683794, 0.0027384196342643613, 0.0023713737056616554, 0.002053525026457146, 0.0017782794100389228, 0.001539926526059492, 0.001333521432163324, 0.0011547819846894581, 0.001, 0.0008659643233600654, 0.0007498942093324559, 0.0006493816315762113, 0.0005623413251903491, 0.0004869675251658631, 0.00042169650342858224, 0.0003651741272548377, 0.00031622776601683794, 0.0002738419634264361, 0.00023713737056616554, 0.0002053525026457146, 0.00017782794100389227, 0.0001539926526059492, 0.0001333521432163324, 0.00011547819846894582};
__device__ __forceinline__ void p0_prologue(const Frame& F, const Args& a) {
    unsigned char* ws = F.ws;
    p0_weight<1>(F, a.in[1], DM, EVEN_IN, EVEN_IN, (bf16_t*)(ws + W0_IN));
    p0_weight<0>(F, a.in[2], DM, DM, DM, (bf16_t*)(ws + W0_OUT));
    p0_weight<0>(F, a.in[4], DM, ODD_IN, ODD_N, (bf16_t*)(ws + W1_IN));
    p0_weight<0>(F, a.in[7], DM, DM, DM, (bf16_t*)(ws + W1_OUT));
    p0_weight<2>(F, a.in[8], DM, 2 * FF, 2 * FF, (bf16_t*)(ws + W0_UP));
    p0_weight<2>(F, a.in[8] + (size_t)DM * 2 * FF, DM, 2 * FF, 2 * FF, (bf16_t*)(ws + W1_UP));
    p0_weight<0>(F, a.in[11], FF, DM, DM, (bf16_t*)(ws + W0_DOWN));
    p0_weight<0>(F, a.in[11] + (size_t)FF * DM, FF, DM, DM, (bf16_t*)(ws + W1_DOWN));
    { const float* x = a.in[0]; bf16_t* xb = (bf16_t*)(ws + WS_XB);
      GRID_STRIDE(i, (size_t)M * DM / 8) { const f32x4 v0 = *(const f32x4*)(x + i * 8), v1 = *(const f32x4*)(x + i * 8 + 4); u32x4 o; o.x = pk2(v0[0], v0[1]); o.y = pk2(v0[2], v0[3]); o.z = pk2(v1[0], v1[1]); o.w = pk2(v1[2], v1[3]); *(u32x4*)(xb + i * 8) = o; } }
    { float* cs = (float*)(ws + T_COS); float* sn = (float*)(ws + T_SIN);
      GRID_STRIDE(i, (size_t)SEQ * 64) { const int ii = (int)(i & 63), t = (int)(i >> 6); const double ang = (double)t * INV_TAB[ii];
          const double kk = __builtin_rint(ang * 0.15915494309189535); const double r = __builtin_fma(-kk, 6.283185307179586, ang) - kk * 2.4492935982947064e-16;
          const float rf = (float)r; cs[i] = cosf(rf); sn[i] = sinf(rf); } }
    { float* bt = (float*)(ws + T_BTAB); const float* rb = a.in[3];
      GRID_STRIDE(i, 3 * 129 * 8) { const int h = (int)(i & 7), j = (int)((i >> 3) % 129), br = (int)(i / (129 * 8)); const int r = br == 0 ? 1 : (br == 1 ? 4 : 16); bt[i] = rb[t5_bucket(j * r) * 8 + h]; } }
}

template <bool WRITE_BF16, bool GATES>
__device__ __forceinline__ void ln_phase(const Frame& F, const float* xres, const float* mix, const float* g, const float* b, float* outp, bf16_t* xb, const float* w_in1, float* gates) {
    const int gw = F.vcu * NWAVES + F.wave, NGW = F.G * NWAVES;
    LAS float* wg = (LAS float*)F.lds;
    const int tid = F.ftid(), lane = tid & 63;
    if (GATES) { for (int i = tid; i < DM * 8; i += NTHR) wg[i] = w_in1[(size_t)(i >> 3) * ODD_IN + ODD_N + (i & 7)]; __syncthreads(); }
    for (int m = gw; m < M; m += NGW) {
        const f32x4* xr = (const f32x4*)(xres + (size_t)m * DM) + lane; const f32x4* mr = (const f32x4*)(mix + (size_t)m * DM) + lane;
        f32x4 v[4]; float s = 0.f;
#pragma unroll
        for (int j = 0; j < 4; ++j) { v[j] = xr[64 * j] * ALPHA + mr[64 * j]; s += (v[j][0] + v[j][1]) + (v[j][2] + v[j][3]); }
        const float mean = wave_sum(s) * (1.f / DM); float s2 = 0.f;
#pragma unroll
        for (int j = 0; j < 4; ++j) { v[j] = v[j] - mean; s2 += (v[j][0] * v[j][0] + v[j][1] * v[j][1]) + (v[j][2] * v[j][2] + v[j][3] * v[j][3]); }
        const float rstd = 1.f / sqrtf(wave_sum(s2) * (1.f / DM) + LN_EPS);
        float ga[8];
        if (GATES) {
#pragma unroll
            for (int q = 0; q < 8; ++q) ga[q] = 0.f;
        }
#pragma unroll
        for (int j = 0; j < 4; ++j) {
            const f32x4 gv = *((const f32x4*)g + lane + 64 * j), bv = *((const f32x4*)b + lane + 64 * j);
            const f32x4 o = v[j] * rstd * gv + bv;
            *((f32x4*)(outp + (size_t)m * DM) + lane + 64 * j) = o;
            if (WRITE_BF16) { u32x2 w; w.x = pk2(o[0], o[1]); w.y = pk2(o[2], o[3]); *((u32x2*)(xb + (size_t)m * DM) + lane + 64 * j) = w; }
            if (GATES) {
#pragma unroll
                for (int e = 0; e < 4; ++e) { const int k = (lane + 64 * j) * 4 + e; const f32x4 wa = *(const LAS f32x4*)(wg + k * 8), wb = *(const LAS f32x4*)(wg + k * 8 + 4);
                    ga[0] = fmaf(o[e], wa[0], ga[0]); ga[1] = fmaf(o[e], wa[1], ga[1]); ga[2] = fmaf(o[e], wa[2], ga[2]); ga[3] = fmaf(o[e], wa[3], ga[3]);
                    ga[4] = fmaf(o[e], wb[0], ga[4]); ga[5] = fmaf(o[e], wb[1], ga[5]); ga[6] = fmaf(o[e], wb[2], ga[6]); ga[7] = fmaf(o[e], wb[3], ga[7]); }
            }
        }
        if (GATES) {
#pragma unroll
            for (int q = 0; q < 8; ++q) ga[q] = wave_sum(ga[q]);
            if (lane == 0) { *(f32x4*)(gates + (size_t)m * 8) = (f32x4){ga[0], ga[1], ga[2], ga[3]}; *(f32x4*)(gates + (size_t)m * 8 + 4) = (f32x4){ga[4], ga[5], ga[6], ga[7]}; }
        }
    }
    if (GATES) __syncthreads();
}

__device__ __forceinline__ void ffn_fix_phase(const float* gst, const float* ust, const float* cw, const float* cb, bf16_t* H) {
    GRID_STRIDE(i, (size_t)256 * 2 * FF) {
        const int ch = (int)(i % FF), r = (int)((i / FF) & 1), blk = (int)(i / (2 * FF));
        const bool first = ((blk * 64) & (SEQ - 1)) == 0;
        float a = cb[ch];
#pragma unroll
        for (int k = 0; k < 3; ++k) { const int idx = r + k; float g;
            if (idx < 2) g = first ? 0.f : gst[((size_t)(blk - 1) * 4 + idx) * FF + ch]; else g = gst[((size_t)blk * 4 + idx) * FF + ch];
            a = fmaf(cw[k * FF + ch], g, a); }
        H[(size_t)(blk * 64 + r) * FF + ch] = (bf16_t)f2bf(silu_f(a) * ust[((size_t)blk * 2 + r) * FF + ch]);
    }
}
__device__ __forceinline__ void qk_fix_phase(const float* st4, const float* cw, bf16_t* O) {
    GRID_STRIDE(i, (size_t)256 * 3 * 2048) {
        const int ch = (int)(i & 2047), r = (int)((i >> 11) % 3), blk = (int)(i / (3 * 2048));
        const bool first = ((blk * 64) & (SEQ - 1)) == 0;
        float a = 0.f;
#pragma unroll
        for (int k = 0; k < 4; ++k) { const int idx = r + k; float g;
            if (idx < 3) g = first ? 0.f : st4[((size_t)(blk - 1) * 6 + idx) * 2048 + ch]; else g = st4[((size_t)blk * 6 + idx) * 2048 + ch];
            a = fmaf(cw[k * 2048 + ch], g, a); }
        O[(size_t)(blk * 64 + r) * ODD_N + ch] = (bf16_t)f2bf(silu_f(a) * (ch >= 1024 ? 0.0625f : 1.f));
    }
}

template <class T> __device__ __forceinline__ float ldv(const T* p);
template <> __device__ __forceinline__ float ldv<float>(const float* p) { return *p; }
template <> __device__ __forceinline__ float ldv<bf16_t>(const bf16_t* p) { return bf2f(*p); }
template <bool TA, bool TB, bool ACC, class TAe, class TBe>
__device__ __forceinline__ void bgemm_phase(const Frame& F, const TAe* A, int lda, long sA1, long sA2, const float* rsA, long sR1, long sR2,
                                            const TBe* B, int ldb, long sB1, long sB2, float* C, int ldc, long sC1, long sC2, int nz, int nz2, int Mt, int N, int K) {
    LAS float* As = (LAS float*)F.lds;
    LAS float* Bs = As + 16 * 129;
    const int tid = F.ftid(), tx = tid & 15, ty = tid >> 4;
    const int tM = Mt / 128, tN = N / 64, ntile = tM * tN * nz;
    for (int vt = blockIdx.x; vt < ntile; vt += gridDim.x) {
        const int z = vt / (tM * tN), rem = vt % (tM * tN), m0 = (rem / tN) * 128, n0 = (rem % tN) * 64;
        const int z1 = z / nz2, z2 = z % nz2;
        const TAe* Az = A + z1 * sA1 + z2 * sA2; const TBe* Bz = B + z1 * sB1 + z2 * sB2; float* Cz = C + z1 * sC1 + z2 * sC2;
        const float* rs = rsA ? rsA + z1 * sR1 + z2 * sR2 : nullptr;
        float acc[4][4];
#pragma unroll
        for (int i = 0; i < 4; ++i)
#pragma unroll
            for (int j = 0; j < 4; ++j) acc[i][j] = 0.f;
        for (int k0 = 0; k0 < K; k0 += 16) {
#pragma unroll
            for (int r = 0; r < 4; ++r) {
                const int idx = tid + r * 512;
                if (!TA) { const int m = idx >> 4, k = idx & 15; float v = ldv(Az + (size_t)(m0 + m) * lda + k0 + k); if (rs) v *= rs[m0 + m]; As[k * 129 + m] = v; }
                else     { const int k = idx >> 7, m = idx & 127; float v = ldv(Az + (size_t)(k0 + k) * lda + m0 + m); if (rs) v *= rs[k0 + k]; As[k * 129 + m] = v; }
            }
#pragma unroll
            for (int r = 0; r < 2; ++r) {
                const int idx = tid + r * 512;
                if (!TB) { const int k = idx >> 6, n = idx & 63; Bs[k * 65 + n] = ldv(Bz + (size_t)(k0 + k) * ldb + n0 + n); }
                else     { const int n = idx >> 4, k = idx & 15; Bs[k * 65 + n] = ldv(Bz + (size_t)(n0 + n) * ldb + k0 + k); }
            }
            __syncthreads();
#pragma unroll
            for (int k = 0; k < 16; ++k) {
                float av[4], bv[4];
#pragma unroll
                for (int i = 0; i < 4; ++i) { av[i] = As[k * 129 + ty * 4 + i]; bv[i] = Bs[k * 65 + tx * 4 + i]; }
#pragma unroll
                for (int i = 0; i < 4; ++i)
#pragma unroll
                    for (int j = 0; j < 4; ++j) acc[i][j] = fmaf(av[i], bv[j], acc[i][j]);
            }
            __syncthreads();
        }
#pragma unroll
        for (int i = 0; i < 4; ++i)
#pragma unroll
            for (int j = 0; j < 4; ++j) { float* p = Cz + (size_t)(m0 + ty * 4 + i) * ldc + n0 + tx * 4 + j; *p = ACC ? (*p + acc[i][j]) : acc[i][j]; }
    }
}

__device__ __forceinline__ void dsa_naive_phase(const bf16_t* h0  , const float* btab, bf16_t* ymix  ) {
    GRID_STRIDE(gid, (size_t)SEQ * 8) {
        const int h = (int)(gid & 7), t = (int)(gid >> 3);
        const bf16_t* qp = h0 + (size_t)t * EVEN_IN + 2048 + h * 64;
        float q[64], acc[64];
#pragma unroll
        for (int i = 0; i < 64; i += 8) { const u32x4 w = *(const u32x4*)(qp + i);
            q[i] = bflo(w.x) * 0.125f; q[i + 1] = bfhi(w.x) * 0.125f; q[i + 2] = bflo(w.y) * 0.125f; q[i + 3] = bfhi(w.y) * 0.125f;
            q[i + 4] = bflo(w.z) * 0.125f; q[i + 5] = bfhi(w.z) * 0.125f; q[i + 6] = bflo(w.w) * 0.125f; q[i + 7] = bfhi(w.w) * 0.125f; }
#pragma unroll
        for (int i = 0; i < 64; ++i) acc[i] = 0.f;
        float m = -INFINITY, ssum = 0.f;
        for (int br = 0; br < 3; ++br) {
            const int r = br == 0 ? 1 : (br == 1 ? 4 : 16);
            const int lq = t / r; const int jmax = lq < 128 ? lq : 128;
            for (int j = 0; j <= jmax; ++j) {
                const int tk = t - j * r;
                const bf16_t* kp = h0 + (size_t)tk * EVEN_IN + 2560 + h * 64;
                const bf16_t* vp = h0 + (size_t)tk * EVEN_IN + 3072 + h * 64;
                float d0 = 0.f, d1 = 0.f;
#pragma unroll
                for (int i = 0; i < 64; i += 8) { const u32x4 w = *(const u32x4*)(kp + i);
                    d0 = fmaf(q[i], bflo(w.x), d0); d1 = fmaf(q[i + 1], bfhi(w.x), d1); d0 = fmaf(q[i + 2], bflo(w.y), d0); d1 = fmaf(q[i + 3], bfhi(w.y), d1);
                    d0 = fmaf(q[i + 4], bflo(w.z), d0); d1 = fmaf(q[i + 5], bfhi(w.z), d1); d0 = fmaf(q[i + 6], bflo(w.w), d0); d1 = fmaf(q[i + 7], bfhi(w.w), d1); }
                const float logit = d0 + d1 + btab[(br * 129 + j) * 8 + h];
                const float mn = fmaxf(m, logit);
                const float sc = expf(m - mn), p = expf(logit - mn);
                ssum = ssum * sc + p; m = mn;
#pragma unroll
                for (int i = 0; i < 64; i += 8) { const u32x4 w = *(const u32x4*)(vp + i);
                    acc[i] = fmaf(p, bflo(w.x), acc[i] * sc); acc[i + 1] = fmaf(p, bfhi(w.x), acc[i + 1] * sc); acc[i + 2] = fmaf(p, bflo(w.y), acc[i + 2] * sc); acc[i + 3] = fmaf(p, bfhi(w.y), acc[i + 3] * sc);
                    acc[i + 4] = fmaf(p, bflo(w.z), acc[i + 4] * sc); acc[i + 5] = fmaf(p, bfhi(w.z), acc[i + 5] * sc); acc[i + 6] = fmaf(p, bflo(w.w), acc[i + 6] * sc); acc[i + 7] = fmaf(p, bfhi(w.w), acc[i + 7] * sc); }
            }
        }
        const float inv = 1.f / ssum;
        bf16_t* op = ymix + (size_t)t * DM + 512 + h * 64;
#pragma unroll
        for (int i = 0; i < 64; i += 8) { u32x4 w; w.x = pk2(acc[i] * inv, acc[i + 1] * inv); w.y = pk2(acc[i + 2] * inv, acc[i + 3] * inv); w.z = pk2(acc[i + 4] * inv, acc[i + 5] * inv); w.w = pk2(acc[i + 6] * inv, acc[i + 7] * inv); *(u32x4*)(op + i) = w; }
    }
}


namespace mx {
constexpr int LDT = 272;
constexpr int TILE_B = 128 * LDT;
__device__ __forceinline__ f32x4 mfma16(bf16x8 bt, bf16x8 a, f32x4 c) { return __builtin_amdgcn_mfma_f32_16x16x32_bf16(bt, a, c, 0, 0, 0); }
__device__ __forceinline__ bf16x8 ldfrag(const LAS unsigned char* base, int row, int ldb, int k) { return *(const LAS bf16x8*)(base + row * ldb + k * 2); }
template <int ROWS, int COLS>
__device__ __forceinline__ void stage(LAS unsigned char* dst, int ldb, const bf16_t* src, size_t src_ld, int tid) {
    constexpr int CPR = COLS / 8, TOTAL = ROWS * CPR;
#pragma unroll
    for (int it = 0; it < TOTAL / NTHR; ++it) { const int idx = tid + it * NTHR, r = idx / CPR, c = idx % CPR;
        const u32x4 v = *(const u32x4*)(src + (size_t)r * src_ld + c * 8);
        *(LAS u32x4*)(dst + r * ldb + c * 16) = v; }
}
template <int ROWS, int COLS, int SCALE>
__device__ __forceinline__ void stage_T(LAS unsigned char* dst, int ldb, const bf16_t* src, size_t src_ld, int tid, float sc_a, float sc_b, const LAS float* sarr = nullptr) {
    constexpr int CPR = COLS / 8, TOTAL = ROWS * CPR;
#pragma unroll
    for (int it = 0; it < TOTAL / NTHR; ++it) { const int idx = tid + it * NTHR, r = idx % ROWS, c = idx / ROWS;
        const u32x4 v = *(const u32x4*)(src + (size_t)r * src_ld + c * 8);
        float f[8] = {bflo(v.x), bfhi(v.x), bflo(v.y), bfhi(v.y), bflo(v.z), bfhi(v.z), bflo(v.w), bfhi(v.w)};
        const float sc = SCALE == 1 ? exp2f(sc_a * (sc_b - (float)r)) : (SCALE == 2 ? sarr[r] : 1.f);
        LAS bf16_t* d = (LAS bf16_t*)(dst + (c * 8) * ldb) + r;
#pragma unroll
        for (int j = 0; j < 8; ++j) *(LAS bf16_t*)((LAS unsigned char*)d + j * ldb) = SCALE ? (bf16_t)f2bf(f[j] * sc) : (bf16_t)(__builtin_bit_cast(unsigned, f[j]) >> 16); }
}
template <int ROWS, int COLS>
__device__ __forceinline__ void stage_f32(LAS unsigned char* dst, int ldb, const float* src, int tid) {
    constexpr int CPR = COLS / 8, TOTAL = ROWS * CPR;
#pragma unroll
    for (int it = 0; it < TOTAL / NTHR; ++it) { const int idx = tid + it * NTHR, r = idx / CPR, c = idx % CPR;
        const f32x4 a = *(const f32x4*)(src + (size_t)r * COLS + c * 8), b = *(const f32x4*)(src + (size_t)r * COLS + c * 8 + 4);
        u32x4 w; w.x = pk2(a[0], a[1]); w.y = pk2(a[2], a[3]); w.z = pk2(b[0], b[1]); w.w = pk2(b[2], b[3]);
        *(LAS u32x4*)(dst + r * ldb + c * 16) = w; }
}

__device__ __forceinline__ void ret_kv_unit(LAS unsigned char* lds, const bf16_t* h0, float* kvT, int u) {
    const int tid = fresh_tid(), lane = tid & 63, w = __builtin_amdgcn_readfirstlane(tid >> 6), r = lane & 15, q = lane >> 4;
    const int b = u >> 7, h = (u >> 5) & 3, n = u & 31;
    const size_t row0 = (size_t)b * SEQ + n * 128;
    LAS unsigned char* VT = lds; LAS unsigned char* KT = lds + TILE_B;
    const float lg2 = ret_lg(h) * 1.4426950408889634f;
    stage_T<128, 128, 0>(VT, LDT, h0 + row0 * EVEN_IN + 1024 + h * 128, EVEN_IN, tid, 0.f, 0.f);
    stage_T<128, 128, 1>(KT, LDT, h0 + row0 * EVEN_IN + 512 + h * 128, EVEN_IN, tid, lg2, 127.f);
    __syncthreads();
    f32x4 acc[8];
#pragma unroll
    for (int nt = 0; nt < 8; ++nt) acc[nt] = (f32x4){0.f, 0.f, 0.f, 0.f};
#pragma unroll
    for (int ks = 0; ks < 4; ++ks) { const bf16x8 a = ldfrag(VT, 16 * w + r, LDT, 32 * ks + 8 * q);
#pragma unroll
        for (int nt = 0; nt < 8; ++nt) acc[nt] = mfma16(ldfrag(KT, 16 * nt + r, LDT, 32 * ks + 8 * q), a, acc[nt]); }
    float* op = kvT + (size_t)u * 16384 + (16 * w + r) * 128 + 4 * q;
#pragma unroll
    for (int nt = 0; nt < 8; ++nt) *(f32x4*)(op + 16 * nt) = acc[nt];
    __syncthreads();
}
__device__ __forceinline__ void ret_out_unit(LAS unsigned char* lds, const bf16_t* h0, const float* RT  , bf16_t* ymix, int u) {
    const int tid = fresh_tid(), lane = tid & 63, w = __builtin_amdgcn_readfirstlane(tid >> 6), r = lane & 15, q = lane >> 4;
    const int b = u >> 7, h = (u >> 5) & 3, n = u & 31;
    const size_t row0 = (size_t)b * SEQ + n * 128;
    LAS unsigned char* Qs = lds; LAS unsigned char* Ks = lds + TILE_B; LAS unsigned char* VT = lds + 2 * TILE_B; LAS unsigned char* Sl = lds + 3 * TILE_B;
    const float lg2 = ret_lg(h) * 1.4426950408889634f;
    stage<128, 128>(Qs, LDT, h0 + row0 * EVEN_IN + h * 128, EVEN_IN, tid);
    stage<128, 128>(Ks, LDT, h0 + row0 * EVEN_IN + 512 + h * 128, EVEN_IN, tid);
    stage_T<128, 128, 0>(VT, LDT, h0 + row0 * EVEN_IN + 1024 + h * 128, EVEN_IN, tid, 0.f, 0.f);
    __syncthreads();
    const int c = 16 * w + r;
    bf16x8 qf[4];
#pragma unroll
    for (int ks = 0; ks < 4; ++ks) qf[ks] = ldfrag(Qs, c, LDT, 32 * ks + 8 * q);
    for (int nt = 0; nt <= (w | 1); ++nt) {
        f32x4 a4 = (f32x4){0.f, 0.f, 0.f, 0.f};
#pragma unroll
        for (int ks = 0; ks < 4; ++ks) a4 = mfma16(ldfrag(Ks, 16 * nt + r, LDT, 32 * ks + 8 * q), qf[ks], a4);
        float v[4];
#pragma unroll
        for (int jj = 0; jj < 4; ++jj) { const int sidx = 16 * nt + 4 * q + jj; v[jj] = (c >= sidx) ? a4[jj] * exp2f(lg2 * (float)(c - sidx)) : 0.f; }
        u32x2 pw; pw.x = pk2(v[0], v[1]); pw.y = pk2(v[2], v[3]);
        *(LAS u32x2*)(Sl + c * LDT + (16 * nt + 4 * q) * 2) = pw;
    }
    f32x4 y[8];
#pragma unroll
    for (int nt = 0; nt < 8; ++nt) y[nt] = (f32x4){0.f, 0.f, 0.f, 0.f};
    for (int ks = 0; ks <= (w >> 1); ++ks) { const bf16x8 a = ldfrag(Sl, c, LDT, 32 * ks + 8 * q);
#pragma unroll
        for (int nt = 0; nt < 8; ++nt) y[nt] = mfma16(ldfrag(VT, 16 * nt + r, LDT, 32 * ks + 8 * q), a, y[nt]); }
    __syncthreads();
    stage_f32<128, 128>(Ks, LDT, RT + (size_t)u * 16384, tid);
    __syncthreads();
    f32x4 y2[8];
#pragma unroll
    for (int nt = 0; nt < 8; ++nt) y2[nt] = (f32x4){0.f, 0.f, 0.f, 0.f};
#pragma unroll
    for (int ks = 0; ks < 4; ++ks) {
#pragma unroll
        for (int nt = 0; nt < 8; ++nt) y2[nt] = mfma16(ldfrag(Ks, 16 * nt + r, LDT, 32 * ks + 8 * q), qf[ks], y2[nt]); }
    const float qw = exp2f(lg2 * (float)(c + 1));
    float sum = 0.f;
#pragma unroll
    for (int nt = 0; nt < 8; ++nt) { y[nt] = y[nt] + y2[nt] * qw; sum += (y[nt][0] + y[nt][1]) + (y[nt][2] + y[nt][3]); }
    sum += __shfl_xor(sum, 16); sum += __shfl_xor(sum, 32);
    const float mean = sum * (1.f / 128.f); float sq = 0.f;
#pragma unroll
    for (int nt = 0; nt < 8; ++nt) { y[nt] = y[nt] - mean; sq += (y[nt][0] * y[nt][0] + y[nt][1] * y[nt][1]) + (y[nt][2] * y[nt][2] + y[nt][3] * y[nt][3]); }
    sq += __shfl_xor(sq, 16); sq += __shfl_xor(sq, 32);
    const float rstd = 1.f / sqrtf(sq * (1.f / 128.f) + LN_EPS);
    const bf16_t* gp = h0 + (row0 + c) * EVEN_IN + 1536 + h * 128 + 4 * q;
    bf16_t* op = ymix + (row0 + c) * DM + h * 128 + 4 * q;
#pragma unroll
    for (int nt = 0; nt < 8; ++nt) { const u32x2 gw = *(const u32x2*)(gp + 16 * nt);
        const float o0 = y[nt][0] * rstd * silu_acc(bflo(gw.x)), o1 = y[nt][1] * rstd * silu_acc(bfhi(gw.x)), o2 = y[nt][2] * rstd * silu_acc(bflo(gw.y)), o3 = y[nt][3] * rstd * silu_acc(bfhi(gw.y));
        u32x2 ow; ow.x = pk2(o0, o1); ow.y = pk2(o2, o3); *(u32x2*)(op + 16 * nt) = ow; }
    __syncthreads();
}

template <int BR>
__device__ __forceinline__ void dsa_unit(LAS unsigned char* lds, const bf16_t* h0, const float* btab, bf16_t* ymix, float* ms, int u) {
    constexpr int RD = BR == 0 ? 1 : (BR == 1 ? 4 : 16), NBLK = 32 / RD;
    constexpr int LDK = 144, LDV = 560, LDP = 336;
    const int tid = fresh_tid(), lane = tid & 63, w = __builtin_amdgcn_readfirstlane(tid >> 6), r = lane & 15, q = lane >> 4;
    const int b = u >> 8, h = (u >> 5) & 7, idx = u & 31, nb = idx % NBLK, rho = idx / NBLK;
    LAS unsigned char* Ks = lds; LAS unsigned char* VT = lds + 256 * LDK; LAS unsigned char* Pl = VT + 64 * LDV + w * (16 * LDP); LAS float* bias = (LAS float*)(lds + 256 * LDK + 64 * LDV + 8 * 16 * LDP);
    const size_t rowq0 = (size_t)b * SEQ + (size_t)(128 * nb) * RD + rho;
    const bf16_t* kbase = h0 + ((long)rowq0 - (long)128 * RD) * EVEN_IN + 2560 + h * 64;
    const bf16_t* vbase = kbase + 512;
    if (nb > 0) { stage<256, 64>(Ks, LDK, kbase, (size_t)RD * EVEN_IN, tid); stage_T<256, 64, 0>(VT, LDV, vbase, (size_t)RD * EVEN_IN, tid, 0.f, 0.f); }
    else {
        stage<128, 64>(Ks + 128 * LDK, LDK, kbase + (size_t)128 * RD * EVEN_IN, (size_t)RD * EVEN_IN, tid);
        stage_T<128, 64, 0>(VT + 256, LDV, vbase + (size_t)128 * RD * EVEN_IN, (size_t)RD * EVEN_IN, tid, 0.f, 0.f);
        for (int i = tid; i < 64 * 16; i += NTHR) *(LAS u32x4*)(VT + (i >> 4) * LDV + (i & 15) * 16) = (u32x4){0u, 0u, 0u, 0u};
    }
    if (tid < 64 * 2) *(LAS u32x4*)(VT + (tid >> 1) * LDV + 512 + (tid & 1) * 16) = (u32x4){0u, 0u, 0u, 0u};
    if (tid < 129) bias[tid] = btab[(BR * 129 + tid) * 8 + h] * 1.4426950408889634f;
    const int c = 16 * w + r;
    const bf16_t* qp = h0 + (rowq0 + (size_t)c * RD) * EVEN_IN + 2048 + h * 64 + 8 * q;
    const bf16x8 qf0 = *(const bf16x8*)qp, qf1 = *(const bf16x8*)(qp + 32);
    __syncthreads();
    f32x4 sc[9]; float mx = -INFINITY;
#pragma unroll
    for (int t = 0; t < 9; ++t) {
        const int nt = w + t;
        f32x4 a4 = (f32x4){0.f, 0.f, 0.f, 0.f};
        a4 = mfma16(ldfrag(Ks, 16 * nt + r, LDK, 8 * q), qf0, a4);
        a4 = mfma16(ldfrag(Ks, 16 * nt + r, LDK, 32 + 8 * q), qf1, a4);
#pragma unroll
        for (int jj = 0; jj < 4; ++jj) { const int kj = 16 * nt + 4 * q + jj, dist = 128 + c - kj;
            const bool ok = (dist >= 0) && (dist <= 128) && (nb > 0 || kj >= 128);
            const float lg = ok ? fmaf(a4[jj], 0.125f * 1.4426950408889634f, bias[ok ? dist : 0]) : -INFINITY;
            a4[jj] = lg; mx = fmaxf(mx, lg); }
        sc[t] = a4;
    }
    mx = fmaxf(mx, __shfl_xor(mx, 16)); mx = fmaxf(mx, __shfl_xor(mx, 32));
    float ssum = 0.f;
#pragma unroll
    for (int t = 0; t < 9; ++t) { float pv[4];
#pragma unroll
        for (int jj = 0; jj < 4; ++jj) { pv[jj] = exp2f(sc[t][jj] - mx); ssum += pv[jj]; }
        u32x2 pw; pw.x = pk2(pv[0], pv[1]); pw.y = pk2(pv[2], pv[3]);
        *(LAS u32x2*)(Pl + r * LDP + (16 * t + 4 * q) * 2) = pw; }
    *(LAS u32x2*)(Pl + r * LDP + (144 + 4 * q) * 2) = (u32x2){0u, 0u};
    ssum += __shfl_xor(ssum, 16); ssum += __shfl_xor(ssum, 32);
    f32x4 o[4];
#pragma unroll
    for (int dt = 0; dt < 4; ++dt) o[dt] = (f32x4){0.f, 0.f, 0.f, 0.f};
#pragma unroll
    for (int ks = 0; ks < 5; ++ks) { const bf16x8 a = ldfrag(Pl, r, LDP, 32 * ks + 8 * q);
#pragma unroll
        for (int dt = 0; dt < 4; ++dt) o[dt] = mfma16(ldfrag(VT, 16 * dt + r, LDV, 16 * w + 32 * ks + 8 * q), a, o[dt]); }
    const size_t row = rowq0 + (size_t)c * RD;
    float* msp = ms + (row * 8 + h) * 2;
    bf16_t* op = ymix + row * DM + 512 + h * 64 + 4 * q;
    float a0 = 0.f, a1 = 1.f, sn = ssum, mn = mx;
    if (BR > 0) { const f32x2 st = *(const f32x2*)msp; mn = fmaxf(st[0], mx); a0 = st[1] * exp2f(st[0] - mn); a1 = exp2f(mx - mn); sn = a0 + a1 * ssum; }
    const float inv = 1.f / sn;
#pragma unroll
    for (int dt = 0; dt < 4; ++dt) {
        f32x4 v = o[dt] * a1;
        if (BR > 0) { const u32x2 pw = *(const u32x2*)(op + 16 * dt); v[0] += bflo(pw.x) * a0; v[1] += bfhi(pw.x) * a0; v[2] += bflo(pw.y) * a0; v[3] += bfhi(pw.y) * a0; }
        u32x2 ow; ow.x = pk2(v[0] * inv, v[1] * inv); ow.y = pk2(v[2] * inv, v[3] * inv); *(u32x2*)(op + 16 * dt) = ow; }
    if (BR < 2 && q == 0) *(f32x2*)msp = (f32x2){mn, sn};
    __syncthreads();
}

constexpr int LDW = 528;
__device__ __forceinline__ void ml_gates(LAS float* A, LAS float* LI, LAS float* tmp, const float* gates, const float* gate_b, size_t row0, int h, int tid) {
    if (tid < 128) { const float* gp = gates + (row0 + tid) * 8; LI[tid] = gp[h] + gate_b[h]; tmp[tid] = log_sigmoid_f(gp[4 + h] + gate_b[4 + h]); }
    __syncthreads();
    if (tid < 128) { float c = 0.f; for (int j = 0; j <= tid; ++j) c += tmp[j]; A[tid] = c; }
    __syncthreads();
}
__device__ __forceinline__ void ml_kv_unit(LAS unsigned char* lds, const bf16_t* h1, const float* gates, const float* gate_b, bf16_t* kvT, float* ksum, float* gch, int u) {
    const int tid = fresh_tid(), lane = tid & 63, w = __builtin_amdgcn_readfirstlane(tid >> 6), r = lane & 15, q = lane >> 4;
    const int b = u >> 7, h = (u >> 5) & 3, n = u & 31;
    const size_t row0 = (size_t)b * SEQ + n * 128;
    LAS unsigned char* VT = lds; LAS unsigned char* KT = lds + 256 * LDT;
    LAS float* A = (LAS float*)(lds + 512 * LDT); LAS float* LI = A + 128; LAS float* W = LI + 128; LAS float* EW = W + 128; LAS float* red = EW + 128;
    ml_gates(A, LI, W, gates, gate_b, row0, h, tid);
    const float g = A[127];
    if (tid < 128) W[tid] = g - A[tid] + LI[tid];
    __syncthreads();
    float ml = -INFINITY;
    if (tid < 128) { for (int j = 0; j < 128; ++j) ml = fmaxf(ml, W[j]); EW[tid] = expf(W[tid] - ml); if (tid == 0) { gch[u * 2] = g; gch[u * 2 + 1] = ml; } }
    __syncthreads();
    stage_T<128, 256, 0>(VT, LDT, h1 + row0 * ODD_N + 2048 + h * 256, ODD_N, tid, 0.f, 0.f);
    stage_T<128, 256, 2>(KT, LDT, h1 + row0 * ODD_N + 1024 + h * 256, ODD_N, tid, 0.f, 0.f, EW);
    __syncthreads();
    if (tid < 256) { float a = 0.f;
#pragma unroll
        for (int cch = 0; cch < 16; ++cch) { const u32x4 v = *(const LAS u32x4*)(KT + tid * LDT + cch * 16); a += (bflo(v.x) + bfhi(v.x)) + (bflo(v.y) + bfhi(v.y)) + (bflo(v.z) + bfhi(v.z)) + (bflo(v.w) + bfhi(v.w)); }
        ksum[(size_t)u * 256 + tid] = a; }
    bf16_t* outp = kvT + (size_t)u * 65536;
#pragma unroll
    for (int half = 0; half < 2; ++half) {
        f32x4 acc[2][8];
#pragma unroll
        for (int mt = 0; mt < 2; ++mt)
#pragma unroll
            for (int nt = 0; nt < 8; ++nt) acc[mt][nt] = (f32x4){0.f, 0.f, 0.f, 0.f};
#pragma unroll
        for (int ks = 0; ks < 4; ++ks) { const bf16x8 a0 = ldfrag(VT, 32 * w + r, LDT, 32 * ks + 8 * q), a1 = ldfrag(VT, 32 * w + 16 + r, LDT, 32 * ks + 8 * q);
#pragma unroll
            for (int nt = 0; nt < 8; ++nt) { const bf16x8 bt = ldfrag(KT, 128 * half + 16 * nt + r, LDT, 32 * ks + 8 * q); acc[0][nt] = mfma16(bt, a0, acc[0][nt]); acc[1][nt] = mfma16(bt, a1, acc[1][nt]); } }
#pragma unroll
        for (int mt = 0; mt < 2; ++mt)
#pragma unroll
            for (int nt = 0; nt < 8; ++nt) { u32x2 ow; ow.x = pk2(acc[mt][nt][0], acc[mt][nt][1]); ow.y = pk2(acc[mt][nt][2], acc[mt][nt][3]);
                *(u32x2*)(outp + (size_t)(32 * w + 16 * mt + r) * 256 + 128 * half + 16 * nt + 4 * q) = ow; }
    }
    __syncthreads();
}
__device__ __forceinline__ void ml_scan_phase(bf16_t* kvT, float* ksum, const float* gch, float* mprev) {
    GRID_STRIDE(gid, 16 * 8192) {
        const int bh = (int)(gid >> 13), e = (int)((gid >> 5) & 255), i0 = (int)(gid & 31) * 8;
        float C[8], ns[8];
#pragma unroll
        for (int j = 0; j < 8; ++j) { C[j] = 0.f; ns[j] = 0.f; }
        float ms = 0.f;
        for (int n = 0; n < 32; ++n) {
            const int u = bh * 32 + n; const float gn = gch[u * 2], mn = gch[u * 2 + 1];
            const float mnew = fmaxf(gn + ms, mn); const float aold = expf(gn + ms - mnew), aloc = expf(mn - mnew);
            bf16_t* p = kvT + (size_t)u * 65536 + e * 256 + i0;
            const u32x4 v = *(const u32x4*)p;
            const float t[8] = {bflo(v.x), bfhi(v.x), bflo(v.y), bfhi(v.y), bflo(v.z), bfhi(v.z), bflo(v.w), bfhi(v.w)};
            u32x4 o; o.x = pk2(C[0], C[1]); o.y = pk2(C[2], C[3]); o.z = pk2(C[4], C[5]); o.w = pk2(C[6], C[7]);
            *(u32x4*)p = o;
#pragma unroll
            for (int j = 0; j < 8; ++j) C[j] = aold * C[j] + aloc * t[j];
            if (e == 0) { float* kp = ksum + (size_t)u * 256 + i0; const f32x4 k0 = *(const f32x4*)kp, k1 = *(const f32x4*)(kp + 4);
                *(f32x4*)kp = (f32x4){ns[0], ns[1], ns[2], ns[3]}; *(f32x4*)(kp + 4) = (f32x4){ns[4], ns[5], ns[6], ns[7]};
#pragma unroll
                for (int j = 0; j < 4; ++j) { ns[j] = aold * ns[j] + aloc * k0[j]; ns[4 + j] = aold * ns[4 + j] + aloc * k1[j]; }
                if (i0 == 0) mprev[u] = ms; }
            ms = mnew;
        }
    }
}
__device__ __forceinline__ void ml_out_unit(LAS unsigned char* lds, const bf16_t* h1, const float* gates, const float* gate_b, const bf16_t* CT, const float* nprev, const float* mprev, bf16_t* ymix, int u) {
    const int tid = fresh_tid(), lane = tid & 63, w = __builtin_amdgcn_readfirstlane(tid >> 6), r = lane & 15, q = lane >> 4;
    const int b = u >> 7, h = (u >> 5) & 3, n = u & 31;
    const size_t row0 = (size_t)b * SEQ + n * 128;
    LAS unsigned char* RB = lds;
    LAS unsigned char* Pl = lds + 256 * LDT;
    LAS float* A = (LAS float*)(lds + 256 * LDT + TILE_B); LAS float* LI = A + 128; LAS float* T = LI + 128; LAS float* PM = T + 128; LAS float* NP = PM + 128;
    ml_gates(A, LI, T, gates, gate_b, row0, h, tid);
    if (tid < 128) T[tid] = LI[tid] - A[tid];
    if (tid >= 256) NP[tid - 256] = nprev[(size_t)u * 256 + tid - 256];
    __syncthreads();
    if (tid < 128) { float m = -INFINITY; for (int j = 0; j <= tid; ++j) m = fmaxf(m, T[j]); PM[tid] = m; }
    stage<128, 256>(RB, LDW, h1 + row0 * ODD_N + 1024 + h * 256, ODD_N, tid);
    const int c = 16 * w + r;
    bf16x8 qf[8];
    { const bf16_t* qp = h1 + (row0 + c) * ODD_N + h * 256 + 8 * q;
#pragma unroll
      for (int ks = 0; ks < 8; ++ks) qf[ks] = *(const bf16x8*)(qp + 32 * ks); }
    __syncthreads();
    const float mp = mprev[u];
    const float ac = A[c], mrow = ac + fmaxf(mp, PM[c]), winter = expf(ac + mp - mrow);
    float den = 0.f;
#pragma unroll
    for (int nt = 0; nt < 8; ++nt) {
        if (nt <= (w | 1)) {
            f32x4 a4 = (f32x4){0.f, 0.f, 0.f, 0.f};
#pragma unroll
            for (int ks = 0; ks < 8; ++ks) a4 = mfma16(ldfrag(RB, 16 * nt + r, LDW, 32 * ks + 8 * q), qf[ks], a4);
            float v[4];
#pragma unroll
            for (int jj = 0; jj < 4; ++jj) { const int sidx = 16 * nt + 4 * q + jj; v[jj] = (c >= sidx) ? expf(ac + T[sidx] - mrow) * a4[jj] : 0.f; den += v[jj]; }
            u32x2 pw; pw.x = pk2(v[0], v[1]); pw.y = pk2(v[2], v[3]);
            *(LAS u32x2*)(Pl + c * LDT + (16 * nt + 4 * q) * 2) = pw;
        }
    }
    { float d2 = 0.f;
#pragma unroll
      for (int ks = 0; ks < 8; ++ks)
#pragma unroll
          for (int j = 0; j < 8; ++j) d2 = fmaf(bf2f((unsigned short)qf[ks][j]), NP[32 * ks + 8 * q + j], d2);
      den += winter * d2; }
    den += __shfl_xor(den, 16); den += __shfl_xor(den, 32);
    __syncthreads();
    stage_T<128, 256, 0>(RB, LDT, h1 + row0 * ODD_N + 2048 + h * 256, ODD_N, tid, 0.f, 0.f);
    __syncthreads();
    f32x4 num[16];
#pragma unroll
    for (int nt = 0; nt < 16; ++nt) num[nt] = (f32x4){0.f, 0.f, 0.f, 0.f};
    for (int ks = 0; ks <= (w >> 1); ++ks) { const bf16x8 a = ldfrag(Pl, c, LDT, 32 * ks + 8 * q);
#pragma unroll
        for (int nt = 0; nt < 16; ++nt) num[nt] = mfma16(ldfrag(RB, 16 * nt + r, LDT, 32 * ks + 8 * q), a, num[nt]); }
#pragma unroll
    for (int half = 0; half < 2; ++half) {
        __syncthreads();
        stage<128, 256>(RB, LDW, CT + (size_t)u * 65536 + (size_t)half * 128 * 256, 256, tid);
        __syncthreads();
        f32x4 n2[8];
#pragma unroll
        for (int nt = 0; nt < 8; ++nt) n2[nt] = (f32x4){0.f, 0.f, 0.f, 0.f};
#pragma unroll
        for (int ks = 0; ks < 8; ++ks) {
#pragma unroll
            for (int nt = 0; nt < 8; ++nt) n2[nt] = mfma16(ldfrag(RB, 16 * nt + r, LDW, 32 * ks + 8 * q), qf[ks], n2[nt]); }
#pragma unroll
        for (int nt = 0; nt < 8; ++nt) num[8 * half + nt] = num[8 * half + nt] + n2[nt] * winter;
    }
    const float dinv = 1.f / fmaxf(fabsf(den), expf(-mrow));
    const bf16_t* og = h1 + (row0 + c) * ODD_N + 3072 + h * 256 + 4 * q;
    bf16_t* op = ymix + (row0 + c) * DM + h * 256 + 4 * q;
#pragma unroll
    for (int nt = 0; nt < 16; ++nt) { const u32x2 gw = *(const u32x2*)(og + 16 * nt);
        const float o0 = num[nt][0] * dinv * sigmoid_f(bflo(gw.x)), o1 = num[nt][1] * dinv * sigmoid_f(bfhi(gw.x)), o2 = num[nt][2] * dinv * sigmoid_f(bflo(gw.y)), o3 = num[nt][3] * dinv * sigmoid_f(bfhi(gw.y));
        u32x2 ow; ow.x = pk2(o0, o1); ow.y = pk2(o2, o3); *(u32x2*)(op + 16 * nt) = ow; }
    __syncthreads();
}
}
#define GRID_BAR() xcd_barrier(bar)
template <int layer>
__device__ __forceinline__ void run_layer(const Frame& F, const Args& args, const XcdBarrier& bar) {
    unsigned char* ws = F.ws; float* out = F.out; const float* x_in = args.in[0];
    const float* ln_g = args.in[12]; const float* ln_b = args.in[13];
    bf16_t* XB = (bf16_t*)(ws + WS_XB); LAS unsigned char* ring = F.lds;
        const float* xres = (layer == 0) ? x_in : out;
        float* mixo;
        if (layer == 0) {
            { pg8::Gemm g{XB, (const bf16_t*)(ws + W0_IN), DM, EVEN_IN, DM}; pg8::StaticOrder S; S.init(M, EVEN_IN, F.G, (int)blockIdx.x);
              pg8::EpiH0 E{(bf16_t*)(ws + L0_H), (const float*)(ws + T_COS), (const float*)(ws + T_SIN)};
              pg8::gemm_phase<pg8::EpiH0, true>(ring, g, S, E); }
            GRID_BAR();
            { const bf16_t* h0 = (const bf16_t*)(ws + L0_H); float* kvT = (float*)(ws + L0_SCR);
              const float* btab = (const float*)(ws + T_BTAB); float* dms = (float*)(ws + F_GST);
              for (int u = blockIdx.x; u < 512; u += gridDim.x) mx::ret_kv_unit(F.lds, h0, kvT, u);
              for (int u = blockIdx.x; u < 1024; u += gridDim.x) mx::dsa_unit<0>(F.lds, h0, btab, XB, dms, u);
              GRID_BAR();
              for (int u = blockIdx.x; u < 1024; u += gridDim.x) mx::dsa_unit<1>(F.lds, h0, btab, XB, dms, u);
              GRID_STRIDE(gid, 16 * 16384) { const int bh = (int)(gid >> 14), ie = (int)(gid & 16383); const float cd = expf(ret_lg(bh & 3) * 128.f); float R = 0.f;
                  for (int n = 0; n < 32; ++n) { float* p = kvT + ((size_t)(bh * 32 + n) << 14) + ie; const float tmp = *p; *p = R; R = cd * R + tmp; } }
              GRID_BAR();
              for (int u = blockIdx.x; u < 512; u += gridDim.x) mx::ret_out_unit(F.lds, h0, kvT, XB, u);
              for (int u = blockIdx.x; u < 1024; u += gridDim.x) mx::dsa_unit<2>(F.lds, h0, btab, XB, dms, u);
              GRID_BAR(); }
            mixo = (float*)(ws + L0_MIX);
            { pg8::Gemm g{XB, (const bf16_t*)(ws + W0_OUT), DM, DM, DM}; pg8::StaticOrder S; S.init(M, DM, F.G, (int)blockIdx.x);
              pg8::EpiF32 E{mixo, DM}; pg8::gemm_phase<pg8::EpiF32, false, true>(ring, g, S, E); }
            GRID_BAR();
        } else {
            { pg8::Gemm g{XB, (const bf16_t*)(ws + W1_IN), DM, ODD_N, DM}; pg8::StaticOrder S; S.init(M, ODD_N, F.G, (int)blockIdx.x);
              pg8::EpiH1 E{(bf16_t*)(ws + L1_H), args.in[6], (float*)(ws + L1_ST4)};
              pg8::gemm_phase<pg8::EpiH1, true>(ring, g, S, E); }
            GRID_BAR();
            qk_fix_phase((const float*)(ws + L1_ST4), args.in[6], (bf16_t*)(ws + L1_H));
            GRID_BAR();
            { const bf16_t* h1 = (const bf16_t*)(ws + L1_H); const float* gates = (const float*)(ws + T_GATES); const float* gate_b = args.in[5];
              bf16_t* kvT = (bf16_t*)(ws + L1_SCR); float* ksum = (float*)(ws + T_SMALL); float* gch = ksum + 512 * 256; float* mpv = gch + 1024;
              for (int u = blockIdx.x; u < 512; u += gridDim.x) mx::ml_kv_unit(F.lds, h1, gates, gate_b, kvT, ksum, gch, u);
              GRID_BAR();
              mx::ml_scan_phase(kvT, ksum, gch, mpv);
              GRID_BAR();
              for (int u = blockIdx.x; u < 512; u += gridDim.x) mx::ml_out_unit(F.lds, h1, gates, gate_b, kvT, ksum, mpv, XB, u);
              GRID_BAR(); }
            mixo = (float*)(ws + L1_MIX);
            { pg8::Gemm g{XB, (const bf16_t*)(ws + W1_OUT), DM, DM, DM}; pg8::StaticOrder S; S.init(M, DM, F.G, (int)blockIdx.x);
              pg8::EpiF32 E{mixo, DM}; pg8::gemm_phase<pg8::EpiF32, false, true>(ring, g, S, E); }
            GRID_BAR();
        }
        ln_phase<true, false>(F, xres, mixo, ln_g + (layer * 2 + 0) * DM, ln_b + (layer * 2 + 0) * DM, out, XB, nullptr, nullptr);
        GRID_BAR();
        { pg8::Gemm g{XB, (const bf16_t*)(ws + (layer == 0 ? W0_UP : W1_UP)), DM, 2 * FF, DM}; pg8::StaticOrder S; S.init(M, 2 * FF, F.G, (int)blockIdx.x);
          pg8::EpiFfn E{(bf16_t*)(ws + F_H), args.in[9] + (size_t)layer * 3 * FF, args.in[10] + (size_t)layer * FF, (float*)(ws + F_GST), (float*)(ws + F_UST)};
          pg8::gemm_phase<pg8::EpiFfn, true>(ring, g, S, E); }
        GRID_BAR();
        ffn_fix_phase((const float*)(ws + F_GST), (const float*)(ws + F_UST), args.in[9] + (size_t)layer * 3 * FF, args.in[10] + (size_t)layer * FF, (bf16_t*)(ws + F_H));
        GRID_BAR();
        { pg8::Gemm g{(const bf16_t*)(ws + F_H), (const bf16_t*)(ws + (layer == 0 ? W0_DOWN : W1_DOWN)), FF, DM, FF}; pg8::StaticOrder S; S.init(M, DM, F.G, (int)blockIdx.x);
          pg8::EpiF32 E{(float*)(ws + F_MIX), DM}; pg8::gemm_phase<pg8::EpiF32, false, true>(ring, g, S, E); }
        GRID_BAR();
        if (layer == 0) ln_phase<true, true>(F, out, (const float*)(ws + F_MIX), ln_g + (layer * 2 + 1) * DM, ln_b + (layer * 2 + 1) * DM, out, XB, args.in[4], (float*)(ws + T_GATES));
        else ln_phase<false, false>(F, out, (const float*)(ws + F_MIX), ln_g + (layer * 2 + 1) * DM, ln_b + (layer * 2 + 1) * DM, out, nullptr, nullptr, nullptr);
        if (layer == 0) GRID_BAR();
    }

__global__ void __launch_bounds__(NTHR, 2) fwd_megakernel(Args args) {
    extern __shared__ __attribute__((aligned(16))) unsigned char lds_raw[];
    cg::grid_group grid = cg::this_grid();
    Frame F;
    F.lds = (LAS unsigned char*)lds_raw;
    F.wave = __builtin_amdgcn_readfirstlane(threadIdx.x >> 6);
    F.G = gridDim.x; { const int bx = blockIdx.x; F.vcu = (F.G % 8 == 0) ? (bx % 8) * (F.G / 8) + bx / 8 : bx; }
    F.ws = args.ws; F.out = args.out;
    unsigned char* ws = args.ws;
    volatile LAS unsigned* MISC = (volatile LAS unsigned*)(F.lds + MISC_OFF);
    for (int u = threadIdx.x; u < (LDS_BYTES - LDSCTL_OFF) / 4; u += NTHR) ((LAS unsigned*)(F.lds + LDSCTL_OFF))[u] = 0u;
    __syncthreads();
    XcdBarrier bar = xcd_barrier_post((unsigned*)(ws + WS_CTL) + 4096, MISC + 8);

    p0_prologue(F, args);
    grid.sync();

    run_layer<0>(F, args, bar);
    run_layer<1>(F, args, bar);
}
static_assert(T_SMALL + (512 * 256 + 1024 + 512) * 4 <= WS_W1, "small arrays");
static_assert(6 * 4 * SEQ + 3 * 128 + 32768 + 32768 <= 196608 && L1_SCR + 56 * MiB + (size_t)NB * 196608 * 4 <= WS_END, "naive mLSTM smalls");

extern "C" void kernel_launch(void* const* d_in, const int* in_sizes, int n_in, void* d_out, int out_size, void* d_ws, size_t ws_size, hipStream_t stream) {
    static int grid = 0;
    if (grid == 0) {
        if (n_in != 14 || ws_size < WS_END) { fprintf(stderr, "kernel_launch: unexpected n_in %d / ws %zu\n", n_in, ws_size); grid = -1; return; }
        int dev = 0, cus = 0, per_cu = 0;
        hipGetDevice(&dev);
        hipDeviceGetAttribute(&cus, hipDeviceAttributeMultiprocessorCount, dev);
        if (hipFuncSetAttribute((const void*)fwd_megakernel, hipFuncAttributeMaxDynamicSharedMemorySize, LDS_BYTES) != hipSuccess) { fprintf(stderr, "kernel_launch: hipFuncSetAttribute failed\n"); grid = -1; return; }
        if (hipOccupancyMaxActiveBlocksPerMultiprocessor(&per_cu, (const void*)fwd_megakernel, NTHR, LDS_BYTES) != hipSuccess || per_cu < 1) { fprintf(stderr, "kernel_launch: occupancy query says %d\n", per_cu); per_cu = 1; }
        (void)hipGetLastError();
        grid = cus * 1;
        fprintf(stderr, "kernel_launch: grid %d (cus %d, per_cu %d)\n", grid, cus, per_cu);
    }
    if (grid < 0) return;
    hipMemsetAsync((char*)d_ws + WS_CTL, 0, CTL_ZERO_BYTES, stream);
    Args a{};
    for (int i = 0; i < 14; ++i) a.in[i] = (const float*)d_in[i];
    a.out = (float*)d_out; a.ws = (unsigned char*)d_ws;
    void* kargs[] = {&a};
    hipError_t e = hipLaunchCooperativeKernel((const void*)fwd_megakernel, dim3(grid), dim3(NTHR), kargs, LDS_BYTES, stream);
    if (e != hipSuccess) fprintf(stderr, "cooperative launch failed: %s (grid %d)\n", hipGetErrorString(e), grid);
}
```
